# Optimizing an MI355X kernel written in HIP

```python
import jax, jax.numpy as jnp
from jax import lax
import numpy as np

D_MODEL = 1024
BATCH = 8
SEQ = 4096
DEPTH = 2

D_MIX = D_MODEL
HEAD_DIM = 64
CONV_WIDTH = (D_MIX * 3) // 8
FOURIER_WIDTH = D_MIX // 4
SGU_WIDTH = D_MIX - CONV_WIDTH - FOURIER_WIDTH
CONV_HEADS = CONV_WIDTH // HEAD_DIM
FOURIER_GROUPS = FOURIER_WIDTH // HEAD_DIM
SGU_HEADS = SGU_WIDTH // HEAD_DIM
W_IN_COLS = 2 * CONV_WIDTH + FOURIER_WIDTH + 2 * SGU_WIDTH
CONV_KSIZE = 31
SGU_CHUNK = 128
N_EXPERTS = 64
N_EXPERT_GROUPS = 8
EXPERTS_PER_GROUP = N_EXPERTS // N_EXPERT_GROUPS
TOP_K = 2
D_FF_EXPERT = D_MODEL // 2
EXPERT_BLOCK = 128
N_MOD = 6
EPS = 1e-6

kernel_name = "hybrid_conv_fourier_sgu_grouped_moe_encoder"


def rmsnorm(x, g):
    xf = x.astype(jnp.float32)
    y = xf * lax.rsqrt(jnp.mean(xf * xf, axis=-1, keepdims=True) + EPS)
    return (y * g.astype(jnp.float32)).astype(x.dtype)


def layernorm(x, g, b):
    xf = x.astype(jnp.float32)
    mu = jnp.mean(xf, axis=-1, keepdims=True)
    var = jnp.mean(jnp.square(xf - mu), axis=-1, keepdims=True)
    y = (xf - mu) * lax.rsqrt(var + EPS)
    return (y * g.astype(jnp.float32) + b.astype(jnp.float32)).astype(x.dtype)


def conv_module(za, conv_w, conv_b, gn_g, gn_b):
    a, g = jnp.split(za, 2, axis=-1)
    h = a * jax.nn.sigmoid(g)
    h = lax.conv_general_dilated(
        h, conv_w.reshape(CONV_KSIZE, 1, CONV_WIDTH).astype(h.dtype),
        window_strides=(1,), padding=[(CONV_KSIZE // 2, CONV_KSIZE // 2)],
        dimension_numbers=("NWC", "WIO", "NWC"),
        feature_group_count=CONV_WIDTH) + conv_b
    Bsz, S, _ = h.shape
    hg = h.reshape(Bsz, S, CONV_HEADS, HEAD_DIM)
    hg = layernorm(hg, jnp.ones((HEAD_DIM,), jnp.float32), jnp.zeros((HEAD_DIM,), jnp.float32))
    h = hg.reshape(Bsz, S, CONV_WIDTH) * gn_g + gn_b
    return jax.nn.silu(h)


def fourier_mix(zb):
    Bsz, S, _ = zb.shape
    xg = zb.reshape(Bsz, S, FOURIER_GROUPS, HEAD_DIM).astype(jnp.float32)
    f = jnp.fft.fftn(xg, axes=(1, 3), norm="ortho").real
    return f.reshape(Bsz, S, FOURIER_WIDTH).astype(zb.dtype)


def spatial_gating(zc, ln_g, ln_b, w_s, b_s):
    z = jax.nn.gelu(zc)
    u, v = jnp.split(z, 2, axis=-1)
    v = layernorm(v, ln_g, ln_b)
    Bsz, S, _ = v.shape
    vc = v.reshape(Bsz, S // SGU_CHUNK, SGU_CHUNK, SGU_HEADS, HEAD_DIM)
    vs = jnp.einsum("hpq,bnqhd->bnphd", w_s, vc) + b_s.T[:, :, None]
    return u * vs.reshape(Bsz, S, SGU_WIDTH)


def token_mixer(h, w_in, w_out, conv_w, conv_b, gn_g, gn_b, ln_g, ln_b, w_s, b_s):
    z = h @ w_in
    za = z[..., :2 * CONV_WIDTH]
    zb = z[..., 2 * CONV_WIDTH:2 * CONV_WIDTH + FOURIER_WIDTH]
    zc = z[..., 2 * CONV_WIDTH + FOURIER_WIDTH:]
    ya = conv_module(za, conv_w, conv_b, gn_g, gn_b)
    yb = fourier_mix(zb)
    yc = spatial_gating(zc, ln_g, ln_b, w_s, b_s)
    return jnp.concatenate([ya, yb, yc], axis=-1) @ w_out


def moe(h, router_w, router_b, w1, w3, w2):
    Bsz, S, D = h.shape
    N = Bsz * S
    M = N * TOP_K
    xt = h.reshape(N, D)
    probs = jax.nn.softmax((xt @ router_w).astype(jnp.float32), axis=-1)
    sel = probs + router_b.astype(jnp.float32)
    sel_g = sel.reshape(N, N_EXPERT_GROUPS, EXPERTS_PER_GROUP)
    gscore = jnp.sum(lax.top_k(sel_g, TOP_K)[0], axis=-1)
    gidx = jnp.argmax(gscore, axis=-1)
    in_grp = jnp.take_along_axis(sel_g, gidx[:, None, None], axis=1)[:, 0]
    _, local = lax.top_k(in_grp, TOP_K)
    eidx = gidx[:, None] * EXPERTS_PER_GROUP + local
    gw = jnp.take_along_axis(probs, eidx, axis=1)
    gw = gw / jnp.sum(gw, axis=-1, keepdims=True)

    e_flat = eidx.reshape(M).astype(jnp.int32)
    tok = jnp.arange(M, dtype=jnp.int32) // TOP_K
    w_flat = gw.reshape(M)
    order = jnp.argsort(e_flat)
    e_s, t_s, w_s = e_flat[order], tok[order], w_flat[order]
    counts = jnp.bincount(e_flat, length=N_EXPERTS).astype(jnp.int32)
    starts = jnp.cumsum(counts) - counts
    pcounts = (counts + EXPERT_BLOCK - 1) // EXPERT_BLOCK * EXPERT_BLOCK
    pends = jnp.cumsum(pcounts)
    pstarts = pends - pcounts
    dest = pstarts[e_s] + (jnp.arange(M, dtype=jnp.int32) - starts[e_s])
    n_blocks = (M + N_EXPERTS * (EXPERT_BLOCK - 1) + EXPERT_BLOCK - 1) // EXPERT_BLOCK
    xp = jnp.zeros((n_blocks * EXPERT_BLOCK, D), h.dtype).at[dest].set(xt[t_s])
    blk_start = jnp.arange(n_blocks, dtype=jnp.int32) * EXPERT_BLOCK
    blk_e = jnp.minimum(jnp.searchsorted(pends, blk_start, side="right"), N_EXPERTS - 1)

    def expert_block(args):
        xb, e = args
        return (jax.nn.silu(xb @ w1[e]) * (xb @ w3[e])) @ w2[e]

    yp = lax.map(expert_block, (xp.reshape(n_blocks, EXPERT_BLOCK, D), blk_e))
    yp = yp.reshape(n_blocks * EXPERT_BLOCK, D)
    contrib = (yp[dest] * w_s[:, None]).astype(h.dtype)
    y = jnp.zeros((N, D), h.dtype).at[t_s].add(contrib)
    return y.reshape(Bsz, S, D)


def setup_inputs(seed: int = 0) -> dict:
    key = jax.random.key(seed)
    ks = jax.random.split(key, 24)
    f32 = jnp.float32
    nrm = lambda k, shape, s: jax.random.normal(k, shape, f32) * s
    return {
        "x": nrm(ks[0], (BATCH, SEQ, D_MODEL), 1.0),
        "c": nrm(ks[1], (BATCH, D_MODEL), 1.0),
        "ln1_g": 1.0 + nrm(ks[2], (DEPTH, D_MODEL), 0.02),
        "ln2_g": 1.0 + nrm(ks[3], (DEPTH, D_MODEL), 0.02),
        "w_ada": nrm(ks[4], (DEPTH, D_MODEL, N_MOD * D_MODEL), 0.5 * D_MODEL ** -0.5),
        "b_ada": nrm(ks[5], (DEPTH, N_MOD * D_MODEL), 0.02),
        "w_in": nrm(ks[6], (DEPTH, D_MODEL, W_IN_COLS), D_MODEL ** -0.5),
        "w_out": nrm(ks[7], (DEPTH, D_MIX, D_MODEL), D_MIX ** -0.5),
        "conv_w": nrm(ks[8], (DEPTH, CONV_KSIZE, CONV_WIDTH), CONV_KSIZE ** -0.5),
        "conv_b": nrm(ks[9], (DEPTH, CONV_WIDTH), 0.02),
        "conv_gn_g": 1.0 + nrm(ks[10], (DEPTH, CONV_WIDTH), 0.02),
        "conv_gn_b": nrm(ks[11], (DEPTH, CONV_WIDTH), 0.02),
        "sgu_ln_g": 1.0 + nrm(ks[12], (DEPTH, SGU_WIDTH), 0.02),
        "sgu_ln_b": nrm(ks[13], (DEPTH, SGU_WIDTH), 0.02),
        "sgu_w": nrm(ks[14], (DEPTH, SGU_HEADS, SGU_CHUNK, SGU_CHUNK), SGU_CHUNK ** -0.5),
        "sgu_b": 1.0 + nrm(ks[15], (DEPTH, SGU_HEADS, SGU_CHUNK), 0.02),
        "router_w": nrm(ks[16], (D_MODEL, N_EXPERTS), D_MODEL ** -0.5),
        "router_b": nrm(ks[17], (N_EXPERTS,), 0.01),
        "exp_w1": nrm(ks[18], (DEPTH, N_EXPERTS, D_MODEL, D_FF_EXPERT), D_MODEL ** -0.5),
        "exp_w3": nrm(ks[19], (DEPTH, N_EXPERTS, D_MODEL, D_FF_EXPERT), D_MODEL ** -0.5),
        "exp_w2": nrm(ks[20], (DEPTH, N_EXPERTS, D_FF_EXPERT, D_MODEL), D_FF_EXPERT ** -0.5),
        "final_g": 1.0 + nrm(ks[21], (D_MODEL,), 0.02),
    }


def reference(x, c, ln1_g, ln2_g, w_ada, b_ada, w_in, w_out, conv_w, conv_b, conv_gn_g, conv_gn_b,
              sgu_ln_g, sgu_ln_b, sgu_w, sgu_b, router_w, router_b, exp_w1, exp_w3, exp_w2, final_g):
    c_act = jax.nn.silu(c)
    for l in range(DEPTH):
        mod = (c_act @ w_ada[l] + b_ada[l]).reshape(c.shape[0], N_MOD, D_MODEL)[:, :, None, :]
        shift1, scale1, gate1 = mod[:, 0], mod[:, 1], mod[:, 2]
        shift2, scale2, gate2 = mod[:, 3], mod[:, 4], mod[:, 5]
        h = rmsnorm(x, ln1_g[l]) * (1.0 + scale1) + shift1
        x = x + gate1 * token_mixer(h, w_in[l], w_out[l], conv_w[l], conv_b[l], conv_gn_g[l],
                                    conv_gn_b[l], sgu_ln_g[l], sgu_ln_b[l], sgu_w[l], sgu_b[l])
        h = rmsnorm(x, ln2_g[l]) * (1.0 + scale2) + shift2
        x = x + gate2 * moe(h, router_w, router_b, exp_w1[l], exp_w3[l], exp_w2[l])
    return rmsnorm(x, final_g)
```

```cpp
#include <hip/hip_runtime.h>
#include <cstdio>
#include <cstdint>

#ifndef MK_PER_PHASE
#define MK_PER_PHASE 0
#endif
#ifndef PHMASK
#define PHMASK 0xFFFF
#endif
#define PHON(k) (((PHMASK) >> (k)) & 1)

#define LAS __attribute__((address_space(3)))
#define GAS __attribute__((address_space(1)))
typedef unsigned short bf16;
typedef short bf16x8 __attribute__((ext_vector_type(8)));
typedef float f32x4 __attribute__((ext_vector_type(4)));
typedef float f32x2 __attribute__((ext_vector_type(2)));
typedef unsigned u32x4 __attribute__((ext_vector_type(4)));
typedef unsigned u32x2 __attribute__((ext_vector_type(2)));

constexpr int NB_ = 8, SEQ = 4096, DM = 1024, NTOK = NB_ * SEQ;
constexpr int CONVW = 384, FOURW = 256, SGUW_ = 384, NMAIN = 1536, NFOUR = 512, WIN_COLS = 1792;
constexpr int NEXP = 64, DFF = 512, NMOD = 6 * DM;
constexpr float EPS = 1e-6f;
constexpr int NWAVES = 8, NTHREADS = 512;

constexpr size_t MiB = 1u << 20;
constexpr size_t WS_CTL = 0, CTL_ZERO_BYTES = 1 * MiB;
constexpr size_t WS_MOD = 1 * MiB;
constexpr size_t WS_ROUTERT = 1 * MiB + 512 * 1024;
constexpr size_t WS_SGUW = 2 * MiB;
constexpr size_t WS_WINT = 3 * MiB;
constexpr size_t WS_WINF = 9 * MiB;
constexpr size_t WS_WOUTT = 11 * MiB;
constexpr size_t WS_GW = 15 * MiB;
constexpr size_t WS_LIST = 16 * MiB;
constexpr size_t WS_DFT = 24 * MiB;
constexpr size_t WS_W13T = 88 * MiB;
constexpr size_t WS_W2T = 344 * MiB;
constexpr size_t WS_XA = 472 * MiB;
constexpr size_t WS_HB = 600 * MiB;
constexpr size_t WS_ZMAIN = 664 * MiB;
constexpr size_t WS_ZT = 760 * MiB;
constexpr size_t WS_MIX = 792 * MiB;
constexpr size_t WS_CONTRIB = 856 * MiB;
constexpr size_t WS_END = 984 * MiB;
constexpr int CW_TMO = 0, CW_CODE = 1;
constexpr int CW_BAR = 4096;
constexpr int CW_CNT = 16384;
constexpr int CW_CHK = 32768;

constexpr int RING_BYTES = 131072;
constexpr int MISC_OFF = RING_BYTES;
constexpr int LDS_BYTES = 147456;
constexpr int M_BAR = 0, M_CNT = 256, M_PRE = 512, M_DESC = 1024, M_NU = 1152;

#define RLX_AGENT __ATOMIC_RELAXED, __HIP_MEMORY_SCOPE_AGENT
#define LDS_WAIT() asm volatile("s_waitcnt lgkmcnt(0)" ::: "memory")
#define VM_WAIT() asm volatile("s_waitcnt vmcnt(0)" ::: "memory")

__device__ __forceinline__ unsigned f2bf(float f) { unsigned u = __builtin_bit_cast(unsigned, f); return (u + 0x7fffu + ((u >> 16) & 1u)) >> 16; }
__device__ __forceinline__ unsigned pk2(float lo, float hi) { return f2bf(lo) | (f2bf(hi) << 16); }
__device__ __forceinline__ float bf2f(unsigned short b) { return __builtin_bit_cast(float, ((unsigned)b) << 16); }
__device__ __forceinline__ float bflo(unsigned w) { return __builtin_bit_cast(float, w << 16); }
__device__ __forceinline__ float bfhi(unsigned w) { return __builtin_bit_cast(float, w & 0xffff0000u); }
__device__ __forceinline__ float sigmoidf_(float x) { return 1.0f / (1.0f + __expf(-x)); }
__device__ __forceinline__ float gelu_tanh(float x) { const float y = 0.7978845608028654f * (x + 0.044715f * x * x * x); return x * sigmoidf_(2.0f * y); }
__device__ __forceinline__ int opaque_tid() { int t = threadIdx.x; asm volatile("" : "+v"(t)); return t; }
#define PHASE_LOCALS(F) const int tid = opaque_tid(), lane = tid & 63, wave = __builtin_amdgcn_readfirstlane(tid >> 6); unsigned char* ws = (F).ws; asm volatile("" : "+s"(ws)); (void)tid; (void)lane; (void)wave; (void)ws
__device__ __forceinline__ float wave_sum(float v) {
#pragma unroll
    for (int o = 1; o < 64; o <<= 1) v += __shfl_xor(v, o);
    return v;
}

namespace pg8 {
constexpr int BM = 256, BK = 64, HALF = 128, HTB = HALF * BK * 2, STAGE_BYTES = 8 * HTB, NXCD = 8, WGM = 8;
__host__ __device__ __forceinline__ int lds_byte(int r, int c) { const int st = (r >> 4) * 2 + (c >> 5), rr = r & 15, cc = c & 31, ob = rr * 64 + cc * 2; return st * 1024 + (ob ^ (((ob >> 9) & 1) << 5)); }
__host__ __device__ __forceinline__ void stage_rc(int b, int& R, int& C) { const int st = b / 1024, sb = b % 1024, swz = sb ^ (((sb >> 9) & 1) << 5); R = (st >> 1) * 16 + swz / 64; C = (st & 1) * 32 + (swz % 64) / 2; }
__host__ __device__ __forceinline__ int perm32(int rho) { const int n = rho >> 4, i = rho & 15; return 8 * (i >> 2) + 4 * n + (i & 3); }

struct GUnit { const char* a; const char* b; const int* alist; int arow0, nvalid, kind, pm, pn, aux; };

struct StaticMap {
    int nM, nN, nwg;
    __device__ __forceinline__ void init(int M, int N) { nM = M / BM; nN = N / BM; nwg = nM * nN; }
    __device__ __forceinline__ void map(int L, int& pm, int& pn) const {
        int wgid = L; { const int q = nwg / NXCD, r = nwg % NXCD, xcd = wgid % NXCD, off = wgid / NXCD; wgid = (xcd < r ? xcd * (q + 1) : r * (q + 1) + (xcd - r) * q) + off; }
        const int nig = WGM * nN, gid = wgid / nig, fm = gid * WGM, gsz = (nM - fm) < WGM ? (nM - fm) : WGM;
        pm = fm + ((wgid % nig) % gsz); pn = (wgid % nig) / gsz;
    }
};

__device__ __forceinline__ unsigned cvt_pk_bf16(float lo, float hi) { unsigned r; asm volatile("v_cvt_pk_bf16_f32 %0, %1, %2" : "=v"(r) : "v"(lo), "v"(hi)); return r; }

__device__ __forceinline__ void glds16s(const char* sbase, unsigned voff, unsigned lds_dst) {
    unsigned keep;
    asm volatile("s_mov_b32 %0, m0\n\ts_mov_b32 m0, %3\n\ts_nop 0\n\tglobal_load_lds_dwordx4 %1, %2\n\ts_mov_b32 m0, %0" : "=&s"(keep) : "v"(voff), "s"(sbase), "s"(lds_dst) : "memory");
}
template <class Epi, class Sched, bool ALIGN_EPI>
__device__ __forceinline__ void gemm_phase(LAS unsigned char* lds, const int K, const Sched& S, const Epi& E) {
    const int tid = opaque_tid(), wid = __builtin_amdgcn_readfirstlane(tid >> 6), lane = tid & 63, wr = wid >> 2, wc = wid & 3, fr = lane & 15, fq = lane >> 4;
    const int nt = K / BK;
    unsigned voffB[2];
#pragma unroll
    for (int i = 0; i < 2; ++i) { int R, C; stage_rc(tid * 16 + i * 8192, R, C); const int Rb = Epi::PERM ? ((R & ~31) + perm32(R & 31)) : R; voffB[i] = (unsigned)(Rb * K + C) * 2u; }
    const size_t kstep = (size_t)(BK * 2);
    const size_t hstepB = (size_t)HALF * K * 2;
    const unsigned ldsw = (unsigned)wid * 1024u;
    const unsigned ldsb = (unsigned)(size_t)lds;
    const int aoff = lds_byte(wr * 64 + fr, fq * 8), boff = lds_byte(wc * 32 + fr, fq * 8);
#define PG8_SA(b, h) (((b) * 2 + (h)) * HTB)
#define PG8_SB(b, h) ((4 + (b) * 2 + (h)) * HTB)
#define PG8_STAGE_B(bufoff, gbase) do { _Pragma("unroll") for (int _i = 0; _i < 2; ++_i) \
        glds16s((const char*)(gbase), voffB[_i], ldsb + (unsigned)(bufoff) + ldsw + (unsigned)(_i * 8192)); } while (0)
#define PG8_STAGE_A(bufoff, gbase, kb, vo) do { _Pragma("unroll") for (int _i = 0; _i < 2; ++_i) \
        glds16s((const char*)(gbase) + (size_t)(kb), (vo)[_i], ldsb + (unsigned)(bufoff) + ldsw + (unsigned)(_i * 8192)); } while (0)
#define PG8_LOAD_ROWS(dst, u) do { _Pragma("unroll") for (int _h = 0; _h < 2; ++_h) _Pragma("unroll") for (int _i = 0; _i < 2; ++_i) { int _R, _C; stage_rc(tid * 16 + _i * 8192, _R, _C); \
        dst[_h][_i] = S.arow(u, _h * HALF + _R); } } while (0)
#define PG8_ROWS_TO_VO(dst, src) do { _Pragma("unroll") for (int _h = 0; _h < 2; ++_h) _Pragma("unroll") for (int _i = 0; _i < 2; ++_i) { int _R, _C; stage_rc(tid * 16 + _i * 8192, _R, _C); \
        dst[_h][_i] = (unsigned)(S.fin(src[_h][_i]) * K + _C) * 2u; } } while (0)
#define PG8_LDA(dst, b, h) do { _Pragma("unroll") for (int m = 0; m < 4; ++m) _Pragma("unroll") for (int k = 0; k < 2; ++k) dst[m][k] = *(const LAS bf16x8*)(lds + PG8_SA(b, h) + aoff + m * 2048 + k * 1024); } while (0)
#define PG8_LDB(dst, b, h) do { _Pragma("unroll") for (int n = 0; n < 2; ++n) _Pragma("unroll") for (int k = 0; k < 2; ++k) dst[n][k] = *(const LAS bf16x8*)(lds + PG8_SB(b, h) + boff + n * 2048 + k * 1024); } while (0)
#define PG8_MMA(ai, bj, At, Bt) do { __builtin_amdgcn_s_setprio(1); _Pragma("unroll") for (int m = 0; m < 4; ++m) _Pragma("unroll") for (int n = 0; n < 2; ++n) _Pragma("unroll") for (int k = 0; k < 2; ++k) \
        acc[ai][bj][m][n] = __builtin_amdgcn_mfma_f32_16x16x32_bf16(Bt[n][k], At[m][k], acc[ai][bj][m][n], 0, 0, 0); __builtin_amdgcn_s_setprio(0); } while (0)
#define PG8_WAIT_V(n) asm volatile("s_waitcnt vmcnt(" #n ")" ::: "memory")
#define PG8_WAIT_L(n) asm volatile("s_waitcnt lgkmcnt(" #n ")" ::: "memory")
#define PG8_BAR __builtin_amdgcn_s_barrier()
#define PG8_SCHED __builtin_amdgcn_sched_barrier(0)
    GUnit cur, nxt; int ui = 0;
    if (!S.next(0, cur)) return;
    f32x4 acc[2][2][4][2];
#pragma unroll
    for (int a = 0; a < 2; ++a)
#pragma unroll
        for (int b = 0; b < 2; ++b)
#pragma unroll
            for (int m = 0; m < 4; ++m)
#pragma unroll
                for (int n = 0; n < 2; ++n) acc[a][b][m][n] = (f32x4){0.f, 0.f, 0.f, 0.f};
    bf16x8 At[4][2], B0[2][2], B1[2][2];
    unsigned vo[2][2];
    { int r0[2][2]; PG8_LOAD_ROWS(r0, cur); PG8_ROWS_TO_VO(vo, r0); }
    const char* ca = cur.a; const char* cB = cur.b;
    PG8_STAGE_B(PG8_SB(0, 0), cB); PG8_STAGE_B(PG8_SB(0, 1), cB + hstepB); PG8_STAGE_A(PG8_SA(0, 0), ca, 0, vo[0]); PG8_STAGE_A(PG8_SA(0, 1), ca, 0, vo[1]);
    if (wr == 1) PG8_BAR;
    PG8_WAIT_V(2); PG8_BAR;
    PG8_STAGE_B(PG8_SB(1, 0), cB + kstep); PG8_STAGE_A(PG8_SA(1, 0), ca, kstep, vo[0]); PG8_STAGE_B(PG8_SB(1, 1), cB + hstepB + kstep);
    PG8_WAIT_V(6); PG8_BAR;
    for (;;) {
        const bool has_next = S.next(ui + 1, nxt);
        const char* na = has_next ? nxt.a : ca; const char* nB = has_next ? nxt.b : cB;
        for (int t = 0; t < nt; t += 2) {
            const bool last = (t == nt - 2);
            const bool sw = last && has_next;
            const size_t k1 = (size_t)(t + 1) * kstep;
            const char* a2 = last ? na : ca; const size_t k2 = last ? (size_t)0 : (size_t)(t + 2) * kstep;
            const char* b2 = last ? nB : cB + (size_t)(t + 2) * kstep; const char* b3 = b2 + kstep;
            int nr[2][2];
            if (sw) PG8_LOAD_ROWS(nr, nxt);
            PG8_LDB(B0, 0, 0); PG8_LDB(B1, 0, 1); PG8_SCHED; PG8_LDA(At, 0, 0); PG8_STAGE_A(PG8_SA(1, 1), ca, k1, vo[1]);
            PG8_WAIT_V(8); PG8_WAIT_L(0); PG8_BAR; PG8_MMA(0, 0, At, B0); PG8_MMA(0, 1, At, B1); PG8_BAR; PG8_SCHED;
            if (sw) PG8_ROWS_TO_VO(vo, nr);
            PG8_LDA(At, 0, 1); PG8_STAGE_B(PG8_SB(0, 0), b2); PG8_STAGE_B(PG8_SB(0, 1), b2 + hstepB); PG8_STAGE_A(PG8_SA(0, 0), a2, k2, vo[0]);
            PG8_WAIT_V(8); PG8_WAIT_L(0); PG8_BAR; PG8_MMA(1, 0, At, B0); PG8_MMA(1, 1, At, B1); PG8_BAR; PG8_SCHED;
            PG8_LDB(B0, 1, 0); PG8_LDB(B1, 1, 1); PG8_SCHED; PG8_LDA(At, 1, 0); PG8_STAGE_A(PG8_SA(0, 1), a2, k2, vo[1]);
            PG8_WAIT_V(8); PG8_WAIT_L(0); PG8_BAR; PG8_MMA(0, 0, At, B0); PG8_MMA(0, 1, At, B1); PG8_BAR; PG8_SCHED;
            PG8_LDA(At, 1, 1); PG8_STAGE_B(PG8_SB(1, 0), b3); PG8_STAGE_B(PG8_SB(1, 1), b3 + hstepB); PG8_STAGE_A(PG8_SA(1, 0), a2, k2 + kstep, vo[0]);
            PG8_WAIT_V(8); PG8_WAIT_L(0); PG8_BAR; PG8_MMA(1, 0, At, B0); PG8_MMA(1, 1, At, B1); PG8_BAR; PG8_SCHED;
        }
        if constexpr (ALIGN_EPI) { if (wr == 0) PG8_BAR; }
        E(acc, cur, wr, wc, fr, fq);
        if (!has_next) break;
#pragma unroll
        for (int a = 0; a < 2; ++a)
#pragma unroll
            for (int b = 0; b < 2; ++b)
#pragma unroll
                for (int m = 0; m < 4; ++m)
#pragma unroll
                    for (int n = 0; n < 2; ++n) acc[a][b][m][n] = (f32x4){0.f, 0.f, 0.f, 0.f};
        cur = nxt; ca = na; cB = nB; ++ui;
        if constexpr (ALIGN_EPI) { if (wr == 1) PG8_BAR; }
    }
    PG8_WAIT_V(0);
    if constexpr (!ALIGN_EPI) { if (wr == 0) PG8_BAR; }
    PG8_BAR;
#undef PG8_SA
#undef PG8_SB
#undef PG8_STAGE_A
#undef PG8_STAGE_B
#undef PG8_LOAD_ROWS
#undef PG8_ROWS_TO_VO
#undef PG8_LDA
#undef PG8_LDB
#undef PG8_MMA
#undef PG8_WAIT_V
#undef PG8_WAIT_L
#undef PG8_BAR
#undef PG8_SCHED
}
}
using pg8::GUnit;

#define XB_TMO      128
#define XB_XCNT(j)  (256  + 64 * (j))
#define XB_XSUB(j)  (1280 + 64 * (j))
#define XB_XGEN(j)  (2304 + 64 * (j))
#define XB_TOP      3328
#define XB_TOPGEN   3392
#define XCD_BAR_WORDS 3456
#define XB_SPIN_CAP (1u << 18)
__device__ __forceinline__ unsigned xb_ld(unsigned* p)              { return __hip_atomic_load(p, __ATOMIC_RELAXED, __HIP_MEMORY_SCOPE_AGENT); }
__device__ __forceinline__ unsigned xb_add(unsigned* p, unsigned v) { return __hip_atomic_fetch_add(p, v, __ATOMIC_RELAXED, __HIP_MEMORY_SCOPE_AGENT); }
__device__ __forceinline__ unsigned xb_xcc_id() { return (unsigned)__builtin_amdgcn_s_getreg((3 << 11) | 20) & 0xFu; }
#define XB_SPIN(cond, bar) do { unsigned _sp = 0; while (cond) { __builtin_amdgcn_s_sleep(1); \
    if ((++_sp & 255u) == 0u) { if (xb_ld(&(bar)[XB_TMO])) break; if (_sp > XB_SPIN_CAP) { atomicAdd(&(bar)[XB_TMO], 1u); break; } } } } while (0)
struct XcdBarrier { unsigned* bar; unsigned x; volatile LAS unsigned* st; };
__device__ __forceinline__ XcdBarrier xcd_barrier_post(unsigned* bar, volatile LAS unsigned* st) {
    XcdBarrier b; b.bar = bar; b.x = xb_xcc_id(); b.st = st;
    if (threadIdx.x == 0) (void)xb_add(&bar[XB_XCNT(b.x)], 1u);
    return b;
}
__device__ __forceinline__ void xcd_barrier_complete(unsigned* bar, unsigned x, unsigned& nloc, unsigned& nx) {
    const unsigned G = gridDim.x * gridDim.y * gridDim.z;
    unsigned sum, cnt, mine, sp = 0u;
    for (;;) {
        sum = 0u; cnt = 0u; mine = 0u;
#pragma unroll
        for (unsigned j = 0; j < 16; ++j) { const unsigned c = xb_ld(&bar[XB_XCNT(j)]); sum += c; cnt += (c > 0u) ? 1u : 0u; mine = (j == x) ? c : mine; }
        if (sum == G) break;
        __builtin_amdgcn_s_sleep(1);
        if ((++sp & 255u) == 0u) { if (xb_ld(&bar[XB_TMO])) break; if (sp > XB_SPIN_CAP) { atomicAdd(&bar[XB_TMO], 1u); break; } }
    }
    nloc = mine > 0u ? mine : 1u; nx = cnt > 0u ? cnt : 1u;
}
__device__ __forceinline__ void xcd_barrier(const XcdBarrier& b) {
    asm volatile("s_waitcnt vmcnt(0)" ::: "memory");
    __syncthreads();
    if (threadIdx.x == 0) {
        unsigned* bar = b.bar;
        __builtin_amdgcn_s_waitcnt(0);
        unsigned nloc = b.st[0], nx = b.st[1];
        if (nloc == 0u) { xcd_barrier_complete(bar, b.x, nloc, nx); b.st[0] = nloc; b.st[1] = nx; }
        const unsigned old = xb_add(&bar[XB_XSUB(b.x)], 1u);
        const unsigned gen = old / nloc;
        if (old + 1u == (gen + 1u) * nloc) {
            __builtin_amdgcn_fence(__ATOMIC_RELEASE, "agent");
            asm volatile("s_waitcnt vmcnt(0)" ::: "memory");
            const unsigned og = xb_add(&bar[XB_TOP], 1u);
            const unsigned tg = og / nx;
            if (og + 1u == (tg + 1u) * nx) xb_add(&bar[XB_TOPGEN], 1u);
            else XB_SPIN(xb_ld(&bar[XB_TOPGEN]) == tg, bar);
            __builtin_amdgcn_fence(__ATOMIC_ACQUIRE, "agent");
            xb_add(&bar[XB_XGEN(b.x)], 1u);
            asm volatile("s_waitcnt vmcnt(0)" ::: "memory");
        } else {
            XB_SPIN(xb_ld(&bar[XB_XGEN(b.x)]) == gen, bar);
            __builtin_amdgcn_fence(__ATOMIC_ACQUIRE, "agent");
            asm volatile("s_waitcnt vmcnt(0)" ::: "memory");
        }
    }
    __syncthreads();
}

struct Args {
    const float* in[22];
    float* out; unsigned char* ws;
    int ph_lo, ph_hi;
};
struct Frame {
    LAS unsigned char* lds;
    unsigned* ctl;
    int vcu, G, bx;
    unsigned char* ws;
    const Args* A;
    float* out;
};

struct SchedWin {
    static constexpr bool GATHER = false;
    pg8::StaticMap sm; int G, c; const char* hb; const char* wmain; const char* wf;
    __device__ __forceinline__ bool next(int i, GUnit& u) const {
        int L = i * G + c; u.alist = nullptr; u.nvalid = 256;
        if (L < 768) { int pm, pn; sm.map(L, pm, pn); u.a = hb; u.arow0 = pm * 256; u.b = wmain + (size_t)pn * 256 * DM * 2; u.kind = 0; u.pm = pm; u.pn = pn; u.aux = 0; return true; }
        L -= 768; if (L >= 256) return false;
        const int b_ = L & 7, r32 = L >> 3, pm = r32 >> 4, pn = r32 & 15;
        u.a = wf; u.arow0 = pm * 256; u.b = hb + ((size_t)b_ * SEQ + (size_t)pn * 256) * DM * 2; u.kind = 1; u.pm = pm; u.pn = pn; u.aux = b_; return true;
    }
    __device__ __forceinline__ int arow(const GUnit& u, int r) const { return u.arow0 + r; }
    __device__ __forceinline__ int fin(int x) const { return x; }
};
struct EpiWin {
    static constexpr bool PERM = true;
    bf16* zmain; bf16* zt;
    __device__ __forceinline__ void operator()(const f32x4 (&acc)[2][2][4][2], const GUnit& u, int wr, int wc, int fr, int fq) const {
#pragma unroll
        for (int ai = 0; ai < 2; ++ai)
#pragma unroll
            for (int m = 0; m < 4; ++m) {
                const int rr = ai * 128 + wr * 64 + m * 16 + fr;
                bf16* rowp;
                if (u.kind == 0) rowp = zmain + (size_t)(u.pm * 256 + rr) * NMAIN + u.pn * 256 + wc * 32 + 8 * fq;
                else { const int mm = u.pm * 256 + rr; rowp = zt + ((size_t)((u.aux * 256 + (mm & 255)) * 2 + (mm >> 8))) * SEQ + u.pn * 256 + wc * 32 + 8 * fq; }
#pragma unroll
                for (int bj = 0; bj < 2; ++bj) { const f32x4 v0 = acc[ai][bj][m][0], v1 = acc[ai][bj][m][1];
                    u32x4 w; w.x = pg8::cvt_pk_bf16(v0[0], v0[1]); w.y = pg8::cvt_pk_bf16(v0[2], v0[3]); w.z = pg8::cvt_pk_bf16(v1[0], v1[1]); w.w = pg8::cvt_pk_bf16(v1[2], v1[3]);
                    *(u32x4*)(rowp + bj * 128) = w; }
            }
    }
};
struct SchedOne {
    static constexpr bool GATHER = false;
    GUnit u0; bool have;
    __device__ __forceinline__ bool next(int i, GUnit& u) const { if (i != 0 || !have) return false; u = u0; return true; }
    __device__ __forceinline__ int arow(const GUnit& u, int r) const { return u.arow0 + r; }
    __device__ __forceinline__ int fin(int x) const { return x; }
};
struct EpiFourier {
    static constexpr bool PERM = true;
    bf16* mix;
    __device__ __forceinline__ void operator()(const f32x4 (&acc)[2][2][4][2], const GUnit& u, int wr, int wc, int fr, int fq) const {
#pragma unroll
        for (int ai = 0; ai < 2; ++ai)
#pragma unroll
            for (int m = 0; m < 4; ++m) {
                const int rr = ai * 128 + wr * 64 + m * 16 + fr;
                bf16* rowp = mix + (size_t)(u.aux * SEQ + u.pm * 256 + rr) * DM + CONVW + wc * 32 + 8 * fq;
#pragma unroll
                for (int bj = 0; bj < 2; ++bj) { const f32x4 v0 = acc[ai][bj][m][0], v1 = acc[ai][bj][m][1];
                    u32x4 w; w.x = pg8::cvt_pk_bf16(v0[0], v0[1]); w.y = pg8::cvt_pk_bf16(v0[2], v0[3]); w.z = pg8::cvt_pk_bf16(v1[0], v1[1]); w.w = pg8::cvt_pk_bf16(v1[2], v1[3]);
                    *(u32x4*)(rowp + bj * 128) = w; }
            }
    }
};
struct SchedWout {
    static constexpr bool GATHER = false;
    pg8::StaticMap sm; int G, c; const char* mix; const char* wt;
    __device__ __forceinline__ bool next(int i, GUnit& u) const {
        const int L = i * G + c; if (L >= sm.nwg) return false;
        int pm, pn; sm.map(L, pm, pn); u.a = mix; u.arow0 = pm * 256; u.b = wt + (size_t)pn * 256 * DM * 2; u.kind = 0; u.pm = pm; u.pn = pn; u.aux = 0; u.alist = nullptr; u.nvalid = 256; return true;
    }
    __device__ __forceinline__ int arow(const GUnit& u, int r) const { return u.arow0 + r; }
    __device__ __forceinline__ int fin(int x) const { return x; }
};
struct EpiWout {
    static constexpr bool PERM = false;
    const float* xsrc; float* xa; const float* gate;
    __device__ __forceinline__ void operator()(const f32x4 (&acc)[2][2][4][2], const GUnit& u, int wr, int wc, int fr, int fq) const {
        const int b_ = u.pm >> 4; const int col0 = u.pn * 256 + wc * 32 + 4 * fq;
        f32x4 gv[2][2];
#pragma unroll
        for (int bj = 0; bj < 2; ++bj)
#pragma unroll
            for (int n = 0; n < 2; ++n) gv[bj][n] = *(const f32x4*)(gate + (size_t)b_ * NMOD + col0 + bj * 128 + n * 16);
#pragma unroll
        for (int ai = 0; ai < 2; ++ai)
#pragma unroll
            for (int m = 0; m < 4; ++m) { const size_t off = (size_t)(u.pm * 256 + ai * 128 + wr * 64 + m * 16 + fr) * DM + col0;
#pragma unroll
                for (int bj = 0; bj < 2; ++bj)
#pragma unroll
                    for (int n = 0; n < 2; ++n) { const f32x4 xs = *(const f32x4*)(xsrc + off + bj * 128 + n * 16); *(f32x4*)(xa + off + bj * 128 + n * 16) = xs + gv[bj][n] * acc[ai][bj][m][n]; }
                asm volatile("" ::: "memory"); }
    }
};
struct SchedMoe {
    static constexpr bool GATHER = true;
    const volatile LAS unsigned* desc; const volatile LAS int* cnt; int nu; int which;
    const char* hb; const char* hmoe; const char* wt; const int* list;
    __device__ __forceinline__ bool next(int i, GUnit& u) const {
        if (i >= nu) return false;
        const unsigned d = (unsigned)__builtin_amdgcn_readfirstlane((int)desc[i]);
        const int e = d & 63, pn = (d >> 6) & 3, rb = (d >> 8) & 255, blk = d >> 16;
        const int ce = __builtin_amdgcn_readfirstlane(cnt[e]);
        int nv = ce - rb * 256; nv = nv > 256 ? 256 : nv;
        u.alist = list + (size_t)e * NTOK + rb * 256; u.nvalid = nv; u.kind = e; u.pm = blk; u.pn = pn; u.aux = rb; u.arow0 = blk * 256;
        if (which == 1) { u.a = hb; u.b = wt + ((size_t)e * 1024 + (size_t)pn * 256) * DM * 2; }
        else { u.a = hmoe; u.b = wt + ((size_t)e * 1024 + (size_t)pn * 256) * DFF * 2; }
        return true;
    }
    __device__ __forceinline__ int arow(const GUnit& u, int r) const {
        if (which == 1) return (r < u.nvalid) ? u.alist[r] : 0;
        return u.arow0 + r;
    }
    __device__ __forceinline__ int fin(int x) const { return which == 1 ? (x >> 1) : x; }
};
struct EpiMoe1 {
    static constexpr bool PERM = true;
    bf16* hmoe;
    __device__ __forceinline__ void operator()(const f32x4 (&acc)[2][2][4][2], const GUnit& u, int wr, int wc, int fr, int fq) const {
#pragma unroll
        for (int ai = 0; ai < 2; ++ai)
#pragma unroll
            for (int m = 0; m < 4; ++m) {
                const int rr = ai * 128 + wr * 64 + m * 16 + fr;
                bf16* rowp = hmoe + (size_t)(u.pm * 256 + rr) * DFF + u.pn * 128 + wc * 32 + 8 * fq;
                float hv[8];
#pragma unroll
                for (int n = 0; n < 2; ++n)
#pragma unroll
                    for (int j = 0; j < 4; ++j) { const float g = acc[ai][0][m][n][j], uu = acc[ai][1][m][n][j]; hv[n * 4 + j] = g * sigmoidf_(g) * uu; }
                u32x4 w; w.x = pg8::cvt_pk_bf16(hv[0], hv[1]); w.y = pg8::cvt_pk_bf16(hv[2], hv[3]); w.z = pg8::cvt_pk_bf16(hv[4], hv[5]); w.w = pg8::cvt_pk_bf16(hv[6], hv[7]);
                *(u32x4*)rowp = w;
            }
    }
};
struct EpiMoe2 {
    static constexpr bool PERM = true;
    bf16* contrib; const float* gw;
    __device__ __forceinline__ void operator()(const f32x4 (&acc)[2][2][4][2], const GUnit& u, int wr, int wc, int fr, int fq) const {
#pragma unroll
        for (int ai = 0; ai < 2; ++ai)
#pragma unroll
            for (int m = 0; m < 4; ++m) {
                const int rr = ai * 128 + wr * 64 + m * 16 + fr;
                if (rr < u.nvalid) {
                    const int a = u.alist[rr]; const float g = gw[a];
                    bf16* rowp = contrib + (size_t)a * DM + u.pn * 256 + wc * 32 + 8 * fq;
#pragma unroll
                    for (int bj = 0; bj < 2; ++bj) { const f32x4 v0 = acc[ai][bj][m][0] * g, v1 = acc[ai][bj][m][1] * g;
                        u32x4 w; w.x = pg8::cvt_pk_bf16(v0[0], v0[1]); w.y = pg8::cvt_pk_bf16(v0[2], v0[3]); w.z = pg8::cvt_pk_bf16(v1[0], v1[1]); w.w = pg8::cvt_pk_bf16(v1[2], v1[3]);
                        *(u32x4*)(rowp + bj * 128) = w; }
                }
            }
    }
};

__device__ __forceinline__ void transpose_item(const float* W, int ldw, int col0, int k0, bf16* dst, int kdst, LAS float* scr, int lane) {
#pragma unroll 8
    for (int i = 0; i < 32; ++i) { const int kk = 2 * i + (lane >> 5); scr[kk * 33 + (lane & 31)] = W[(size_t)(k0 + kk) * ldw + col0 + (lane & 31)]; }
    LDS_WAIT(); asm volatile("" ::: "memory");
    const int c = lane & 7;
#pragma unroll
    for (int j = 0; j < 4; ++j) { const int n = (lane >> 3) + 8 * j; const LAS float* s = scr + (8 * c) * 33 + n;
        u32x4 o; o.x = pk2(s[0 * 33], s[1 * 33]); o.y = pk2(s[2 * 33], s[3 * 33]); o.z = pk2(s[4 * 33], s[5 * 33]); o.w = pk2(s[6 * 33], s[7 * 33]);
        *(u32x4*)(dst + (size_t)n * kdst + k0 + 8 * c) = o; }
    LDS_WAIT(); asm volatile("" ::: "memory");
}

__device__ __forceinline__ void p0_prologue(Frame& F) {
    PHASE_LOCALS(F);
    float* MOD = (float*)(ws + WS_MOD);
    if (F.bx < 192) {
        LAS float* sc = (LAS float*)F.lds;
        LAS float* red = (LAS float*)(F.lds + 32768);
        const int l = F.bx / 96, cb = F.bx % 96;
        for (int i = tid; i < NB_ * DM; i += NTHREADS) { const float v = F.A->in[1][i]; sc[i] = v * sigmoidf_(v); }
        __syncthreads();
        const int col = cb * 64 + lane, ks = wave;
        float acc[8];
#pragma unroll
        for (int b = 0; b < 8; ++b) acc[b] = 0.f;
        const float* wp = F.A->in[4] + ((size_t)l * DM + (size_t)ks * 128) * NMOD + col;
#pragma unroll 8
        for (int kk = 0; kk < 128; ++kk) { const float w = wp[(size_t)kk * NMOD];
#pragma unroll
            for (int b = 0; b < 8; ++b) acc[b] += sc[b * DM + ks * 128 + kk] * w; }
#pragma unroll
        for (int b = 0; b < 8; ++b) red[(ks * 8 + b) * 64 + lane] = acc[b];
        __syncthreads();
        { const int b = wave; float s = F.A->in[5][(size_t)l * NMOD + col];
#pragma unroll
          for (int k2 = 0; k2 < 8; ++k2) s += red[(k2 * 8 + b) * 64 + lane];
          MOD[((size_t)l * 8 + b) * NMOD + col] = s; }
        __syncthreads();
    }
    const int gw = F.vcu * NWAVES + wave, NGW = F.G * NWAVES;
    const int gt = F.bx * NTHREADS + tid, NGT = F.G * NTHREADS;
    {
        LAS float* ct = (LAS float*)F.lds;
        for (int i = tid; i < 4096; i += NTHREADS) ct[i] = cospif((float)i * (1.0f / 2048.0f)) * (1.0f / 512.0f);
        __syncthreads();
        bf16* dft = (bf16*)(ws + WS_DFT);
        for (int i = gt; i < 4096 * 8192 / 8; i += NGT) {
            const int k = i >> 10, s0 = (i & 1023) * 8; const int part = s0 >> 12, s = s0 & 4095;
            unsigned w[4];
#pragma unroll
            for (int j = 0; j < 4; ++j) {
                const int t0 = ((s + 2 * j) * k + part * 1024) & 4095, t1 = ((s + 2 * j + 1) * k + part * 1024) & 4095;
                w[j] = pk2(ct[t0], ct[t1]); }
            *(u32x4*)(dft + (size_t)k * 8192 + s0) = (u32x4){w[0], w[1], w[2], w[3]};
        }
        __syncthreads();
    }
    { bf16* sw = (bf16*)(ws + WS_SGUW);
      for (int i = gt; i < 2 * 6 * 128 * 128 / 2; i += NGT) { const f32x2 v = *(const f32x2*)(F.A->in[14] + 2 * (size_t)i); *(unsigned*)(sw + 2 * (size_t)i) = pk2(v.x, v.y); } }
    {
        LAS float* t64 = (LAS float*)(F.lds + 16384);
        if (tid < 64) t64[tid] = cospif((float)tid * (1.0f / 32.0f));
        __syncthreads();
        bf16* wf = (bf16*)(ws + WS_WINF);
        for (int it = gw; it < 2 * 4 * 16 * 2 * 4; it += NGW) {
            const int jq = it & 3, part = (it >> 2) & 1, kb = (it >> 3) & 15, g = (it >> 7) & 3, l = it >> 9;
            const int k = kb * 64 + lane;
            const float* src = F.A->in[6] + ((size_t)l * DM + k) * WIN_COLS + 768 + g * 64;
            float wv[64];
#pragma unroll
            for (int c4 = 0; c4 < 16; ++c4) { const f32x4 v = *(const f32x4*)(src + 4 * c4); wv[4 * c4] = v.x; wv[4 * c4 + 1] = v.y; wv[4 * c4 + 2] = v.z; wv[4 * c4 + 3] = v.w; }
            for (int jj = 0; jj < 16; ++jj) { const int j = jq * 16 + jj; float s = 0.f;
#pragma unroll
                for (int c = 0; c < 64; ++c) { const int t = (c * j + (part ? 48 : 0)) & 63; s += wv[c] * t64[t]; }
                wf[((size_t)l * NFOUR + part * 256 + g * 64 + j) * DM + k] = (bf16)f2bf(s); }
        }
        __syncthreads();
    }
    {
        LAS float* scr = (LAS float*)(F.lds + wave * 16384);
        constexpr int I_EXP = 2 * 64 * 3 * 256, I_WIN = 2 * 768, I_WOUT = 2 * 512, I_R = 32;
        for (int it = gw; it < I_EXP + I_WIN + I_WOUT + I_R; it += NGW) {
            int r = it;
            if (r < I_EXP) {
                const int sub = r & 255, mat = r >> 8, which = mat % 3, le = mat / 3;
                if (which < 2) { const int nb = sub & 15, kb = sub >> 4, n0 = nb * 32; const float* W = (which == 0 ? F.A->in[18] : F.A->in[19]) + (size_t)le * DM * DFF;
                    bf16* dst = (bf16*)(ws + WS_W13T) + ((size_t)le * 1024 + (n0 >> 7) * 256 + which * 128 + (n0 & 127)) * DM;
                    transpose_item(W, DFF, n0, kb * 64, dst, DM, scr, lane); }
                else { const int nb = sub & 31, kb = sub >> 5, n0 = nb * 32; const float* W = F.A->in[20] + (size_t)le * DFF * DM;
                    bf16* dst = (bf16*)(ws + WS_W2T) + ((size_t)le * 1024 + n0) * DFF;
                    transpose_item(W, DM, n0, kb * 64, dst, DFF, scr, lane); }
                continue; }
            r -= I_EXP;
            if (r < I_WIN) { const int l = r / 768, sub = r % 768, nb = sub % 48, kb = sub / 48, n0 = nb * 32; const int col0 = n0 < 768 ? n0 : n0 + 256;
                transpose_item(F.A->in[6] + (size_t)l * DM * WIN_COLS, WIN_COLS, col0, kb * 64, (bf16*)(ws + WS_WINT) + ((size_t)l * NMAIN + n0) * DM, DM, scr, lane); continue; }
            r -= I_WIN;
            if (r < I_WOUT) { const int l = r / 512, sub = r % 512, nb = sub & 31, kb = sub >> 5, n0 = nb * 32;
                transpose_item(F.A->in[7] + (size_t)l * DM * DM, DM, n0, kb * 64, (bf16*)(ws + WS_WOUTT) + ((size_t)l * DM + n0) * DM, DM, scr, lane); continue; }
            r -= I_WOUT;
            { const int nb = r & 1, kb = r >> 1, n0 = nb * 32;
              transpose_item(F.A->in[16], NEXP, n0, kb * 64, (bf16*)(ws + WS_ROUTERT) + (size_t)n0 * DM, DM, scr, lane); }
        }
    }
}

__device__ __forceinline__ void norm_phase(Frame& F, int mode, int l) {
    PHASE_LOCALS(F);
    const int gw = F.vcu * NWAVES + wave, NGW = F.G * NWAVES;
    const float* MOD = (const float*)(ws + WS_MOD);
    float* XA = (float*)(ws + WS_XA); bf16* HB = (bf16*)(ws + WS_HB); const bf16* CT = (const bf16*)(ws + WS_CONTRIB);
    for (int row = gw; row < NTOK; row += NGW) {
        const int b = row >> 12;
        const float* src = (mode == 0 ? F.A->in[0] : XA) + (size_t)row * DM + 4 * lane;
        f32x4 v[4];
#pragma unroll
        for (int j = 0; j < 4; ++j) v[j] = *(const f32x4*)(src + 256 * j);
        if (mode != 0) {
            const float* g2 = MOD + ((size_t)(l - 1) * 8 + b) * NMOD + 5 * DM + 4 * lane;
            const bf16* c0 = CT + (size_t)(2 * row) * DM + 4 * lane; const bf16* c1 = c0 + DM;
#pragma unroll
            for (int j = 0; j < 4; ++j) { const f32x4 g = *(const f32x4*)(g2 + 256 * j); const u32x2 a = *(const u32x2*)(c0 + 256 * j), bb = *(const u32x2*)(c1 + 256 * j);
                v[j].x += g.x * (bflo(a.x) + bflo(bb.x)); v[j].y += g.y * (bfhi(a.x) + bfhi(bb.x)); v[j].z += g.z * (bflo(a.y) + bflo(bb.y)); v[j].w += g.w * (bfhi(a.y) + bfhi(bb.y)); }
            if (mode == 1) {
#pragma unroll
                for (int j = 0; j < 4; ++j) *(f32x4*)(XA + (size_t)row * DM + 4 * lane + 256 * j) = v[j]; }
        }
        float ss = 0.f;
#pragma unroll
        for (int j = 0; j < 4; ++j) ss += (v[j].x * v[j].x + v[j].y * v[j].y) + (v[j].z * v[j].z + v[j].w * v[j].w);
        const float rs = rsqrtf(wave_sum(ss) * (1.0f / DM) + EPS);
        if (mode == 2) {
#pragma unroll
            for (int j = 0; j < 4; ++j) { const f32x4 g = *(const f32x4*)(F.A->in[21] + 4 * lane + 256 * j); *(f32x4*)(F.out + (size_t)row * DM + 4 * lane + 256 * j) = v[j] * rs * g; }
        } else {
            const float* mp = MOD + ((size_t)l * 8 + b) * NMOD + 4 * lane;
#pragma unroll
            for (int j = 0; j < 4; ++j) { const f32x4 g = *(const f32x4*)(F.A->in[2] + (size_t)l * DM + 4 * lane + 256 * j), sh = *(const f32x4*)(mp + 256 * j), scl = *(const f32x4*)(mp + DM + 256 * j);
                const f32x4 h = v[j] * rs * g * (scl + 1.0f) + sh;
                *(u32x2*)(HB + (size_t)row * DM + 4 * lane + 256 * j) = (u32x2){pk2(h.x, h.y), pk2(h.z, h.w)}; }
        }
    }
}

__device__ __forceinline__ void conv_unit(Frame& F, int l, int unit) {
    PHASE_LOCALS(F);
    const int st = unit & 31, hd = (unit >> 5) % 6, b = unit / 192, s0 = st * 128;
    const bf16* ZM = (const bf16*)(ws + WS_ZMAIN); bf16* MIX = (bf16*)(ws + WS_MIX);
    LAS float* T = (LAS float*)F.lds;
    for (int idx = tid; idx < 158 * 8; idx += NTHREADS) {
        const int row = idx >> 3, c8 = idx & 7, s = s0 - 15 + row;
        float o[8];
        if (s >= 0 && s < SEQ) {
            const bf16* p = ZM + (size_t)(b * SEQ + s) * NMAIN + hd * 64 + c8 * 8;
            const u32x4 av = *(const u32x4*)p, gv = *(const u32x4*)(p + CONVW);
            const unsigned aw[4] = {av.x, av.y, av.z, av.w}, gq[4] = {gv.x, gv.y, gv.z, gv.w};
#pragma unroll
            for (int j = 0; j < 4; ++j) { o[2 * j] = bflo(aw[j]) * sigmoidf_(bflo(gq[j])); o[2 * j + 1] = bfhi(aw[j]) * sigmoidf_(bfhi(gq[j])); }
        } else {
#pragma unroll
            for (int j = 0; j < 8; ++j) o[j] = 0.f;
        }
#pragma unroll
        for (int j = 0; j < 8; ++j) T[row * 65 + c8 * 8 + j] = o[j];
    }
    __syncthreads();
    {
        const int c = lane, p0 = wave * 16, ch = hd * 64 + c;
        float w[31];
#pragma unroll
        for (int t = 0; t < 31; ++t) w[t] = F.A->in[8][((size_t)l * 31 + t) * CONVW + ch];
        const float bias = F.A->in[9][l * CONVW + ch], gg = F.A->in[10][l * CONVW + ch], gb = F.A->in[11][l * CONVW + ch];
        float in[46];
#pragma unroll
        for (int j = 0; j < 46; ++j) in[j] = T[(p0 + j) * 65 + c];
#pragma unroll
        for (int i = 0; i < 16; ++i) {
            float a = bias;
#pragma unroll
            for (int t = 0; t < 31; ++t) a += w[t] * in[i + t];
            const float mean = wave_sum(a) * (1.0f / 64.0f), d = a - mean;
            const float var = wave_sum(d * d) * (1.0f / 64.0f);
            float y = d * rsqrtf(var + EPS) * gg + gb; y = y * sigmoidf_(y);
            MIX[(size_t)(b * SEQ + s0 + p0 + i) * DM + ch] = (bf16)f2bf(y);
        }
    }
    __syncthreads();
}

__device__ __forceinline__ void sgu_unit(Frame& F, int l, int unit) {
    PHASE_LOCALS(F);
    const int b = unit >> 5, s0 = (unit & 31) * 128;
    const bf16* ZM = (const bf16*)(ws + WS_ZMAIN); bf16* MIX = (bf16*)(ws + WS_MIX); const bf16* SW = (const bf16*)(ws + WS_SGUW);
    LAS bf16* vT = (LAS bf16*)F.lds;
    constexpr int VP = 136;
    for (int grp = 0; grp < 2; ++grp) {
        const int q0 = wave * 16 + grp * 8;
        float val[8][6];
#pragma unroll
        for (int i = 0; i < 8; ++i) {
            const bf16* p = ZM + (size_t)(b * SEQ + s0 + q0 + i) * NMAIN + 1152 + 2 * lane;
#pragma unroll
            for (int j = 0; j < 3; ++j) { const unsigned wv = *(const unsigned*)(p + 128 * j); val[i][2 * j] = gelu_tanh(bflo(wv)); val[i][2 * j + 1] = gelu_tanh(bfhi(wv)); }
        }
        float lg[6], lb[6];
#pragma unroll
        for (int j = 0; j < 3; ++j) { const f32x2 g = *(const f32x2*)(F.A->in[12] + l * SGUW_ + 2 * lane + 128 * j), bb = *(const f32x2*)(F.A->in[13] + l * SGUW_ + 2 * lane + 128 * j); lg[2 * j] = g.x; lg[2 * j + 1] = g.y; lb[2 * j] = bb.x; lb[2 * j + 1] = bb.y; }
#pragma unroll
        for (int i = 0; i < 8; ++i) {
            float s = 0.f;
#pragma unroll
            for (int j = 0; j < 6; ++j) s += val[i][j];
            const float mean = wave_sum(s) * (1.0f / 384.0f); float q = 0.f;
#pragma unroll
            for (int j = 0; j < 6; ++j) { val[i][j] -= mean; q += val[i][j] * val[i][j]; }
            const float rstd = rsqrtf(wave_sum(q) * (1.0f / 384.0f) + EPS);
#pragma unroll
            for (int j = 0; j < 6; ++j) val[i][j] = val[i][j] * rstd * lg[j] + lb[j];
        }
#pragma unroll
        for (int j = 0; j < 6; ++j) { const int ch = 2 * lane + 128 * (j >> 1) + (j & 1);
            u32x4 o; o.x = pk2(val[0][j], val[1][j]); o.y = pk2(val[2][j], val[3][j]); o.z = pk2(val[4][j], val[5][j]); o.w = pk2(val[6][j], val[7][j]);
            *(LAS u32x4*)(vT + ch * VP + q0) = o; }
    }
    __syncthreads();
    {
        const int fr = lane & 15, fq = lane >> 4;
        for (int st = wave; st < 24; st += 8) {
            const int h = st >> 2, p0 = (st & 3) * 32;
            f32x4 acc[2][4];
#pragma unroll
            for (int mi = 0; mi < 2; ++mi)
#pragma unroll
                for (int ni = 0; ni < 4; ++ni) acc[mi][ni] = (f32x4){0.f, 0.f, 0.f, 0.f};
#pragma unroll
            for (int ks = 0; ks < 4; ++ks) {
                bf16x8 af[2], bfr[4];
#pragma unroll
                for (int mi = 0; mi < 2; ++mi) af[mi] = *(const bf16x8*)(SW + ((size_t)(l * 6 + h) * 128 + p0 + 16 * mi + fr) * 128 + ks * 32 + fq * 8);
#pragma unroll
                for (int ni = 0; ni < 4; ++ni) bfr[ni] = *(const LAS bf16x8*)(vT + (h * 64 + 16 * ni + fr) * VP + ks * 32 + fq * 8);
#pragma unroll
                for (int mi = 0; mi < 2; ++mi)
#pragma unroll
                    for (int ni = 0; ni < 4; ++ni) acc[mi][ni] = __builtin_amdgcn_mfma_f32_16x16x32_bf16(bfr[ni], af[mi], acc[mi][ni], 0, 0, 0);
            }
#pragma unroll
            for (int mi = 0; mi < 2; ++mi) {
                const int p = p0 + 16 * mi + fr; const float bias = F.A->in[15][(size_t)(l * 6 + h) * 128 + p];
                const size_t tok = (size_t)(b * SEQ + s0 + p);
#pragma unroll
                for (int ni = 0; ni < 4; ++ni) {
                    const int d = 16 * ni + 4 * fq;
                    const u32x2 uv = *(const u32x2*)(ZM + tok * NMAIN + 768 + h * 64 + d);
                    const float o0 = gelu_tanh(bflo(uv.x)) * (acc[mi][ni][0] + bias), o1 = gelu_tanh(bfhi(uv.x)) * (acc[mi][ni][1] + bias);
                    const float o2 = gelu_tanh(bflo(uv.y)) * (acc[mi][ni][2] + bias), o3 = gelu_tanh(bfhi(uv.y)) * (acc[mi][ni][3] + bias);
                    *(u32x2*)(MIX + tok * DM + 640 + h * 64 + d) = (u32x2){pk2(o0, o1), pk2(o2, o3)};
                }
            }
        }
    }
    __syncthreads();
}

__device__ __forceinline__ void router_phase(Frame& F, int l) {
    PHASE_LOCALS(F);
    const float* MOD = (const float*)(ws + WS_MOD);
    const float* XA = (const float*)(ws + WS_XA); bf16* HB = (bf16*)(ws + WS_HB); const bf16* RT = (const bf16*)(ws + WS_ROUTERT);
    int* LIST = (int*)(ws + WS_LIST); float* GW = (float*)(ws + WS_GW);
    LAS float* LG = (LAS float*)F.lds;
    LAS int* hist = (LAS int*)(F.lds + 33280);
    LAS int* hbase = (LAS int*)(F.lds + 33280 + 256);
    LAS int* sel_e = (LAS int*)(F.lds + 33280 + 512);
    LAS int* sel_p = (LAS int*)(F.lds + 33280 + 512 + 1024);
    LAS float* sel_w = (LAS float*)(F.lds + 33280 + 512 + 2048);
    for (int blk = F.bx; blk < NTOK / 128; blk += F.G) {
        const int rowbase = blk * 128, b = rowbase >> 12;
        if (tid < 64) hist[tid] = 0;
        for (int i = 0; i < 16; ++i) {
            const int row = rowbase + wave * 16 + i;
            const float* src = XA + (size_t)row * DM + 4 * lane;
            f32x4 v[4]; float ss = 0.f;
#pragma unroll
            for (int j = 0; j < 4; ++j) { v[j] = *(const f32x4*)(src + 256 * j); ss += (v[j].x * v[j].x + v[j].y * v[j].y) + (v[j].z * v[j].z + v[j].w * v[j].w); }
            const float rs = rsqrtf(wave_sum(ss) * (1.0f / DM) + EPS);
            const float* mp = MOD + ((size_t)l * 8 + b) * NMOD + 3 * DM + 4 * lane;
#pragma unroll
            for (int j = 0; j < 4; ++j) { const f32x4 g = *(const f32x4*)(F.A->in[3] + (size_t)l * DM + 4 * lane + 256 * j), sh = *(const f32x4*)(mp + 256 * j), scl = *(const f32x4*)(mp + DM + 256 * j);
                const f32x4 h = v[j] * rs * g * (scl + 1.0f) + sh;
                *(u32x2*)(HB + (size_t)row * DM + 4 * lane + 256 * j) = (u32x2){pk2(h.x, h.y), pk2(h.z, h.w)}; }
        }
        VM_WAIT(); __syncthreads();
        {
            const int fr = lane & 15, fq = lane >> 4; const int row = rowbase + wave * 16 + fr;
            f32x4 acc[4];
#pragma unroll
            for (int ni = 0; ni < 4; ++ni) acc[ni] = (f32x4){0.f, 0.f, 0.f, 0.f};
#pragma unroll 4
            for (int ks = 0; ks < 32; ++ks) {
                const bf16x8 a = *(const bf16x8*)(HB + (size_t)row * DM + ks * 32 + fq * 8);
#pragma unroll
                for (int ni = 0; ni < 4; ++ni) { const bf16x8 bb = *(const bf16x8*)(RT + (size_t)(16 * ni + fr) * DM + ks * 32 + fq * 8); acc[ni] = __builtin_amdgcn_mfma_f32_16x16x32_bf16(bb, a, acc[ni], 0, 0, 0); }
            }
#pragma unroll
            for (int ni = 0; ni < 4; ++ni)
#pragma unroll
                for (int j = 0; j < 4; ++j) LG[(wave * 16 + fr) * 65 + 16 * ni + 4 * fq + j] = acc[ni][j];
        }
        __syncthreads();
        if (lane < 16) {
            const int r = wave * 16 + lane; const LAS float* lg = LG + r * 65;
            float mx = lg[0];
            for (int e = 1; e < 64; ++e) mx = fmaxf(mx, lg[e]);
            float sum = 0.f;
            for (int e = 0; e < 64; ++e) sum += __expf(lg[e] - mx);
            const float inv = 1.0f / sum;
            float best = -1e30f; int bg = 0;
            for (int g = 0; g < 8; ++g) {
                float v1 = -1e30f, v2 = -1e30f;
                for (int i = 0; i < 8; ++i) { const float sv = __expf(lg[g * 8 + i] - mx) * inv + F.A->in[17][g * 8 + i]; if (sv > v1) { v2 = v1; v1 = sv; } else if (sv > v2) v2 = sv; }
                const float gs = v1 + v2; if (gs > best) { best = gs; bg = g; }
            }
            float v1 = -1e30f, v2 = -1e30f; int i1 = 0, i2 = 0;
            for (int i = 0; i < 8; ++i) { const float sv = __expf(lg[bg * 8 + i] - mx) * inv + F.A->in[17][bg * 8 + i];
                if (sv > v1) { v2 = v1; i2 = i1; v1 = sv; i1 = i; } else if (sv > v2) { v2 = sv; i2 = i; } }
            const int e0 = bg * 8 + i1, e1 = bg * 8 + i2;
            const float p0 = __expf(lg[e0] - mx) * inv, p1 = __expf(lg[e1] - mx) * inv, den = 1.0f / (p0 + p1);
            sel_e[2 * r] = e0; sel_e[2 * r + 1] = e1; sel_w[2 * r] = p0 * den; sel_w[2 * r + 1] = p1 * den;
            sel_p[2 * r] = atomicAdd((int*)&hist[e0], 1); sel_p[2 * r + 1] = atomicAdd((int*)&hist[e1], 1);
        }
        __syncthreads();
        if (tid < 64) { const int cn = hist[tid]; hbase[tid] = cn ? (int)atomicAdd(F.ctl + CW_CNT + (l * 64 + tid) * 16, (unsigned)cn) : 0; }
        __syncthreads();
        if (tid < 256) { const int r = tid >> 1, k = tid & 1, e = sel_e[tid], slot = hbase[e] + sel_p[tid], a = (rowbase + r) * 2 + k;
            LIST[(size_t)e * NTOK + slot] = a; GW[a] = sel_w[tid]; }
        __syncthreads();
    }
}

__device__ __forceinline__ int moe_setup(Frame& F, int l) {
    PHASE_LOCALS(F);
    volatile LAS int* cnt = (volatile LAS int*)(F.lds + MISC_OFF + M_CNT);
    volatile LAS int* pre = (volatile LAS int*)(F.lds + MISC_OFF + M_PRE);
    volatile LAS unsigned* desc = (volatile LAS unsigned*)(F.lds + MISC_OFF + M_DESC);
    volatile LAS int* nu = (volatile LAS int*)(F.lds + MISC_OFF + M_NU);
    if (tid < 64) cnt[tid] = (int)F.ctl[CW_CNT + (l * 64 + tid) * 16];
    __syncthreads();
    if (tid == 0) {
        int p = 0;
        for (int e = 0; e < 64; ++e) { pre[e] = p; p += (cnt[e] + 255) >> 8; }
        pre[64] = p;
        int n = 0, e = 0;
        for (int L = F.vcu; L < p * 4 && n < 30; L += F.G) { const int blk = L >> 2, pn = L & 3; while (pre[e + 1] <= blk) ++e; desc[n++] = (unsigned)e | ((unsigned)pn << 6) | ((unsigned)(blk - pre[e]) << 8) | ((unsigned)blk << 16); }
        nu[0] = n;
    }
    __syncthreads();
    return __builtin_amdgcn_readfirstlane(nu[0]);
}

constexpr int N_PHASES = 16;
__global__ void __launch_bounds__(NTHREADS, 2) fwd_kernel(Args args) {
    extern __shared__ __attribute__((aligned(16))) unsigned char lds_raw[];
    Frame F;
    F.lds = (LAS unsigned char*)lds_raw;
    F.G = gridDim.x; F.bx = blockIdx.x; F.vcu = (F.G % 8 == 0) ? (F.bx % 8) * (F.G / 8) + F.bx / 8 : F.bx;
    F.ws = args.ws; F.ctl = (unsigned*)(args.ws + WS_CTL); F.out = args.out;
    F.A = &args;
    for (int u = threadIdx.x; u < (LDS_BYTES - MISC_OFF) / 4; u += NTHREADS) ((LAS unsigned*)(F.lds + MISC_OFF))[u] = 0u;
    __syncthreads();
    XcdBarrier bar; bar.bar = F.ctl + CW_BAR; bar.x = 0; bar.st = nullptr;
    if (!MK_PER_PHASE) bar = xcd_barrier_post(F.ctl + CW_BAR, (volatile LAS unsigned*)(F.lds + MISC_OFF + M_BAR));
    const int lo = args.ph_lo, hi = args.ph_hi;
#define IN(k) (lo <= (k) && (k) < hi)
#define GRID_BAR() do { if (!MK_PER_PHASE) xcd_barrier(bar); } while (0)

    if (IN(0)) { if (PHON(0)) p0_prologue(F); GRID_BAR(); }

    for (int l = 0; l < 2; ++l) {
        const int pb = 1 + 7 * l;
        if (IN(pb + 0)) { if (PHON(1)) norm_phase(F, l == 0 ? 0 : 1, l); GRID_BAR(); }
        if (IN(pb + 1)) { if (PHON(2)) {
            PHASE_LOCALS(F);
            SchedWin S; S.sm.init(NTOK, NMAIN); S.G = F.G; S.c = F.bx; S.hb = (const char*)(ws + WS_HB);
            S.wmain = (const char*)(ws + WS_WINT) + (size_t)l * NMAIN * DM * 2; S.wf = (const char*)(ws + WS_WINF) + (size_t)l * NFOUR * DM * 2;
            EpiWin E{(bf16*)(ws + WS_ZMAIN), (bf16*)(ws + WS_ZT)};
            pg8::gemm_phase<EpiWin, SchedWin, true>(F.lds, DM, S, E); }
            GRID_BAR();
        }
        if (IN(pb + 2)) {
            PHASE_LOCALS(F);
            const int x = F.bx & 7, j = F.bx >> 3;
            if (j < 16) { if (PHON(3)) {
                SchedOne S; S.have = true; S.u0.a = (const char*)(ws + WS_DFT); S.u0.arow0 = j * 256; S.u0.b = (const char*)(ws + WS_ZT) + (size_t)x * 256 * 8192 * 2;
                S.u0.alist = nullptr; S.u0.nvalid = 256; S.u0.kind = 0; S.u0.pm = j; S.u0.pn = 0; S.u0.aux = x;
                EpiFourier E{(bf16*)(ws + WS_MIX)};
                pg8::gemm_phase<EpiFourier, SchedOne, false>(F.lds, 8192, S, E); }
            } else {
                const int w = x * ((F.G >> 3) - 16) + (j - 16), NW = F.G - 128;
                if (PHON(4)) for (int u = w; u < 1536; u += NW) conv_unit(F, l, u);
                if (PHON(5)) for (int u = w; u < 256; u += NW) sgu_unit(F, l, u);
            }
            GRID_BAR();
        }
        if (IN(pb + 3)) { if (PHON(6)) {
            PHASE_LOCALS(F);
            SchedWout S; S.sm.init(NTOK, DM); S.G = F.G; S.c = F.bx; S.mix = (const char*)(ws + WS_MIX); S.wt = (const char*)(ws + WS_WOUTT) + (size_t)l * DM * DM * 2;
            EpiWout E{l == 0 ? F.A->in[0] : (const float*)(ws + WS_XA), (float*)(ws + WS_XA), (const float*)(ws + WS_MOD) + (size_t)l * 8 * NMOD + 2 * DM};
            pg8::gemm_phase<EpiWout, SchedWout, true>(F.lds, DM, S, E); }
            GRID_BAR();
        }
        if (IN(pb + 4)) { if (PHON(7)) router_phase(F, l); GRID_BAR(); }
        if (IN(pb + 5)) { if (PHON(8)) {
            PHASE_LOCALS(F);
            const int nu = moe_setup(F, l);
            SchedMoe S; S.desc = (const volatile LAS unsigned*)(F.lds + MISC_OFF + M_DESC); S.cnt = (const volatile LAS int*)(F.lds + MISC_OFF + M_CNT); S.nu = nu; S.which = 1;
            S.hb = (const char*)(ws + WS_HB); S.hmoe = (const char*)(ws + WS_ZMAIN); S.wt = (const char*)(ws + WS_W13T) + (size_t)l * 64 * 1024 * DM * 2; S.list = (const int*)(ws + WS_LIST);
            EpiMoe1 E{(bf16*)(ws + WS_ZMAIN)};
            pg8::gemm_phase<EpiMoe1, SchedMoe, true>(F.lds, DM, S, E); }
            GRID_BAR();
        }
        if (IN(pb + 6)) { if (PHON(9)) {
            PHASE_LOCALS(F);
            const int nu = moe_setup(F, l);
            SchedMoe S; S.desc = (const volatile LAS unsigned*)(F.lds + MISC_OFF + M_DESC); S.cnt = (const volatile LAS int*)(F.lds + MISC_OFF + M_CNT); S.nu = nu; S.which = 2;
            S.hb = (const char*)(ws + WS_HB); S.hmoe = (const char*)(ws + WS_ZMAIN); S.wt = (const char*)(ws + WS_W2T) + (size_t)l * 64 * 1024 * DFF * 2; S.list = (const int*)(ws + WS_LIST);
            EpiMoe2 E{(bf16*)(ws + WS_CONTRIB), (const float*)(ws + WS_GW)};
            pg8::gemm_phase<EpiMoe2, SchedMoe, true>(F.lds, DFF, S, E); }
            GRID_BAR();
        }
    }
    if (IN(15)) {
        if (PHON(10)) norm_phase(F, 2, 2);
        if (!MK_PER_PHASE) {
            if (xb_ld(F.ctl + CW_BAR + XB_TMO) != 0u) { VM_WAIT(); __syncthreads(); const float q = __builtin_nanf("");
                for (size_t i = (size_t)F.bx * NTHREADS + threadIdx.x; i < (size_t)NTOK * DM; i += (size_t)F.G * NTHREADS) F.out[i] = q; }
        }
    }
#undef IN
#undef GRID_BAR
}

extern "C" void kernel_launch(void* const* d_in, const int* in_sizes, int n_in, void* d_out, int out_size, void* d_ws, size_t ws_size, hipStream_t stream) {
    static int grid = 0;
    if (grid == 0) {
        if (n_in != 22 || out_size != NTOK * DM || ws_size < WS_END) { fprintf(stderr, "kernel_launch: unexpected shapes (n_in %d, out %d, ws %zu, need %zu)\n", n_in, out_size, ws_size, (size_t)WS_END); grid = -1; return; }
        int dev = 0, cus = 0, per_cu = 0;
        if (hipGetDevice(&dev) != hipSuccess || hipDeviceGetAttribute(&cus, hipDeviceAttributeMultiprocessorCount, dev) != hipSuccess) { grid = -1; return; }
        if (hipFuncSetAttribute((const void*)fwd_kernel, hipFuncAttributeMaxDynamicSharedMemorySize, LDS_BYTES) != hipSuccess) { fprintf(stderr, "kernel_launch: hipFuncSetAttribute failed\n"); grid = -1; return; }
        if (hipOccupancyMaxActiveBlocksPerMultiprocessor(&per_cu, (const void*)fwd_kernel, NTHREADS, LDS_BYTES) != hipSuccess || per_cu < 1) fprintf(stderr, "kernel_launch: occupancy query says %d\n", per_cu);
        (void)hipGetLastError();
        grid = cus;
        if (grid != 256) fprintf(stderr, "kernel_launch: %d CUs (built for 256)\n", grid);
    }
    if (grid < 0) return;
    (void)hipMemsetAsync((char*)d_ws + WS_CTL, 0, CTL_ZERO_BYTES, stream);
    Args a{};
    for (int i = 0; i < 22; ++i) a.in[i] = (const float*)d_in[i];
    a.out = (float*)d_out; a.ws = (unsigned char*)d_ws;
#if MK_PER_PHASE
    for (int p = 0; p < N_PHASES; ++p) { a.ph_lo = p; a.ph_hi = p + 1; hipLaunchKernelGGL(fwd_kernel, dim3(grid), dim3(NTHREADS), LDS_BYTES, stream, a); }
#else
    a.ph_lo = 0; a.ph_hi = N_PHASES;
    hipLaunchKernelGGL(fwd_kernel, dim3(grid), dim3(NTHREADS), LDS_BYTES, stream, a);
#endif
}
```

```cpp
#include <hip/hip_runtime.h>
#include <cstdio>
#include <cstdint>

#ifndef MK_PER_PHASE
#define MK_PER_PHASE 0
#endif
#ifndef PHMASK
#define PHMASK 0xFFFF
#endif
#define PHON(k) (((PHMASK) >> (k)) & 1)
#ifndef FP8_MODE
#define FP8_MODE 2
#endif
#ifndef PROBE_REP
#define PROBE_REP -1
#endif
#define REPS(k) ((PROBE_REP) == (k) ? 2 : 1)

#define LAS __attribute__((address_space(3)))
#define GAS __attribute__((address_space(1)))
typedef unsigned short bf16;
typedef short bf16x8 __attribute__((ext_vector_type(8)));
typedef float f32x4 __attribute__((ext_vector_type(4)));
typedef float f32x2 __attribute__((ext_vector_type(2)));
typedef unsigned u32x4 __attribute__((ext_vector_type(4)));
typedef unsigned u32x2 __attribute__((ext_vector_type(2)));
typedef int v4i __attribute__((ext_vector_type(4)));
typedef int v8i __attribute__((ext_vector_type(8)));

constexpr int NB_ = 8, SEQ = 4096, DM = 1024, NTOK = NB_ * SEQ;
constexpr int CONVW = 384, FOURW = 256, SGUW_ = 384, NMAIN = 1536, NFOUR = 512, WIN_COLS = 1792;
constexpr int NEXP = 64, DFF = 512, NMOD = 6 * DM;
constexpr float EPS = 1e-6f;
constexpr int NWAVES = 8, NTHREADS = 512;

constexpr size_t MiB = 1u << 20;
constexpr size_t WS_CTL = 0, CTL_ZERO_BYTES = 1 * MiB;
constexpr size_t WS_MOD = 1 * MiB;
constexpr size_t WS_ROUTERT = 1 * MiB + 512 * 1024;
constexpr size_t WS_SGUW = 2 * MiB;
constexpr size_t WS_WINT = 3 * MiB;
constexpr size_t WS_WINF = 9 * MiB;
constexpr size_t WS_WOUTT = 11 * MiB;
constexpr size_t WS_GW = 15 * MiB;
constexpr size_t WS_GWL = 62 * MiB;
constexpr size_t WS_LIST = 16 * MiB;
constexpr size_t WS_TG = 24 * MiB;
constexpr size_t WS_FT1 = 60 * MiB;
constexpr size_t WS_FT2 = 61 * MiB;
constexpr size_t WS_W13T = 88 * MiB;
constexpr size_t WS_H8 = 216 * MiB;
constexpr size_t WS_W2T = 344 * MiB;
constexpr size_t WS_XA = 472 * MiB;
constexpr size_t WS_HB = 600 * MiB;
constexpr size_t WS_ZMAIN = 664 * MiB;
constexpr size_t WS_ZT = 760 * MiB;
constexpr size_t WS_MIX = 792 * MiB;
constexpr size_t WS_CONTRIB = 856 * MiB;
constexpr size_t WS_END = 984 * MiB;
constexpr int CW_TMO = 0, CW_CODE = 1;
constexpr int CW_BAR = 4096;
constexpr int CW_CNT = 16384;
constexpr int CW_CHK = 32768;

constexpr int RING_BYTES = 131072;
constexpr int MISC_OFF = RING_BYTES;
constexpr int LDS_BYTES = 147456;
constexpr int M_BAR = 0, M_CNT = 256, M_PRE = 512, M_DESC = 1024, M_NU = 1152;

#define RLX_AGENT __ATOMIC_RELAXED, __HIP_MEMORY_SCOPE_AGENT
#define LDS_WAIT() asm volatile("s_waitcnt lgkmcnt(0)" ::: "memory")
#define VM_WAIT() asm volatile("s_waitcnt vmcnt(0)" ::: "memory")

__device__ __forceinline__ unsigned f2bf(float f) { unsigned u = __builtin_bit_cast(unsigned, f); return (u + 0x7fffu + ((u >> 16) & 1u)) >> 16; }
__device__ __forceinline__ unsigned pk2(float lo, float hi) { return f2bf(lo) | (f2bf(hi) << 16); }
__device__ __forceinline__ float bf2f(unsigned short b) { return __builtin_bit_cast(float, ((unsigned)b) << 16); }
__device__ __forceinline__ float bflo(unsigned w) { return __builtin_bit_cast(float, w << 16); }
__device__ __forceinline__ float bfhi(unsigned w) { return __builtin_bit_cast(float, w & 0xffff0000u); }
__device__ __forceinline__ unsigned pk4_fp8(float a, float b, float c, float d) {
    int w = __builtin_amdgcn_cvt_pk_fp8_f32(a, b, 0, false); w = __builtin_amdgcn_cvt_pk_fp8_f32(c, d, w, true); return (unsigned)w; }
__device__ __forceinline__ float clamp448(float x) { return fminf(fmaxf(x, -448.0f), 448.0f); }
constexpr float W8_SCALE = 64.0f, H8_SCALE = 4.0f;
__device__ __forceinline__ float sigmoidf_(float x) { return __builtin_amdgcn_rcpf(1.0f + __expf(-x)); }
__device__ __forceinline__ float gelu_tanh(float x) { const float y = 0.7978845608028654f * (x + 0.044715f * x * x * x); return x * sigmoidf_(2.0f * y); }
__device__ __forceinline__ int opaque_tid() { int t = threadIdx.x; asm volatile("" : "+v"(t)); return t; }
#define PHASE_LOCALS(F) const int tid = opaque_tid(), lane = tid & 63, wave = __builtin_amdgcn_readfirstlane(tid >> 6); unsigned char* ws = (F).ws; asm volatile("" : "+s"(ws)); (void)tid; (void)lane; (void)wave; (void)ws
template <int CTRL> __device__ __forceinline__ float dpp_f(float v) { return __builtin_bit_cast(float, __builtin_amdgcn_update_dpp(0, __builtin_bit_cast(int, v), CTRL, 0xf, 0xf, false)); }
__device__ __forceinline__ float wave_sum(float v) {
    v += dpp_f<0xB1>(v);
    v += dpp_f<0x4E>(v);
    v += dpp_f<0x141>(v);
    v += dpp_f<0x140>(v);
    const int iv = __builtin_bit_cast(int, v);
    const float r0 = __builtin_bit_cast(float, __builtin_amdgcn_readlane(iv, 0)), r1 = __builtin_bit_cast(float, __builtin_amdgcn_readlane(iv, 16));
    const float r2 = __builtin_bit_cast(float, __builtin_amdgcn_readlane(iv, 32)), r3 = __builtin_bit_cast(float, __builtin_amdgcn_readlane(iv, 48));
    return (r0 + r1) + (r2 + r3);
}

namespace pg8 {
constexpr int BM = 256, BK = 64, HALF = 128, HTB = HALF * BK * 2, STAGE_BYTES = 8 * HTB, NXCD = 8, WGM = 8;
__host__ __device__ __forceinline__ int lds_byte(int r, int c) { const int st = (r >> 4) * 2 + (c >> 5), rr = r & 15, cc = c & 31, ob = rr * 64 + cc * 2; return st * 1024 + (ob ^ (((ob >> 9) & 1) << 5)); }
__host__ __device__ __forceinline__ void stage_rc(int b, int& R, int& C) { const int st = b / 1024, sb = b % 1024, swz = sb ^ (((sb >> 9) & 1) << 5); R = (st >> 1) * 16 + swz / 64; C = (st & 1) * 32 + (swz % 64) / 2; }
__host__ __device__ __forceinline__ int perm32(int rho) { const int n = rho >> 4, i = rho & 15; return 8 * (i >> 2) + 4 * n + (i & 3); }

struct GUnit { const char* a; const char* b; const int* alist; int arow0, nvalid, kind, pm, pn, aux; };

struct StaticMap {
    int nM, nN, nwg;
    __device__ __forceinline__ void init(int M, int N) { nM = M / BM; nN = N / BM; nwg = nM * nN; }
    __device__ __forceinline__ void map(int L, int& pm, int& pn) const {
        int wgid = L; { const int q = nwg / NXCD, r = nwg % NXCD, xcd = wgid % NXCD, off = wgid / NXCD; wgid = (xcd < r ? xcd * (q + 1) : r * (q + 1) + (xcd - r) * q) + off; }
        const int nig = WGM * nN, gid = wgid / nig, fm = gid * WGM, gsz = (nM - fm) < WGM ? (nM - fm) : WGM;
        pm = fm + ((wgid % nig) % gsz); pn = (wgid % nig) / gsz;
    }
};

__device__ __forceinline__ unsigned cvt_pk_bf16(float lo, float hi) { unsigned r; asm volatile("v_cvt_pk_bf16_f32 %0, %1, %2" : "=v"(r) : "v"(lo), "v"(hi)); return r; }

__device__ __forceinline__ void glds16s(const char* sbase, unsigned voff, unsigned lds_dst) {
    unsigned keep;
    asm volatile("s_mov_b32 %0, m0\n\ts_mov_b32 m0, %3\n\ts_nop 0\n\tglobal_load_lds_dwordx4 %1, %2\n\ts_mov_b32 m0, %0" : "=&s"(keep) : "v"(voff), "s"(sbase), "s"(lds_dst) : "memory");
}
template <class Epi, class Sched, bool ALIGN_EPI, bool FP8 = false>
__device__ __forceinline__ void gemm_phase(LAS unsigned char* lds, const int K, const Sched& S, const Epi& E) {
    const int tid = opaque_tid(), wid = __builtin_amdgcn_readfirstlane(tid >> 6), lane = tid & 63, wr = wid >> 2, wc = wid & 3, fr = lane & 15, fq = lane >> 4;
    const int nt = K / BK;
    unsigned voffB[2];
#pragma unroll
    for (int i = 0; i < 2; ++i) { int R, C; stage_rc(tid * 16 + i * 8192, R, C); const int Rb = Epi::PERM ? ((R & ~31) + perm32(R & 31)) : R; voffB[i] = (unsigned)(Rb * K + C) * 2u; }
    const size_t kstep = (size_t)(BK * 2);
    const size_t hstepB = (size_t)HALF * K * 2;
    const unsigned ldsw = (unsigned)wid * 1024u;
    const unsigned ldsb = (unsigned)(size_t)lds;
    const int aoff = lds_byte(wr * 64 + fr, fq * 8), boff = lds_byte(wc * 32 + fr, fq * 8);
#define PG8_SA(b, h) (((b) * 2 + (h)) * HTB)
#define PG8_SB(b, h) ((4 + (b) * 2 + (h)) * HTB)
#define PG8_STAGE_B(bufoff, gbase) do { _Pragma("unroll") for (int _i = 0; _i < 2; ++_i) \
        glds16s((const char*)(gbase), voffB[_i], ldsb + (unsigned)(bufoff) + ldsw + (unsigned)(_i * 8192)); } while (0)
#define PG8_STAGE_A(bufoff, gbase, kb, vo) do { _Pragma("unroll") for (int _i = 0; _i < 2; ++_i) \
        glds16s((const char*)(gbase) + (size_t)(kb), (vo)[_i], ldsb + (unsigned)(bufoff) + ldsw + (unsigned)(_i * 8192)); } while (0)
#define PG8_LOAD_ROWS(dst, u) do { _Pragma("unroll") for (int _h = 0; _h < 2; ++_h) _Pragma("unroll") for (int _i = 0; _i < 2; ++_i) { int _R, _C; stage_rc(tid * 16 + _i * 8192, _R, _C); \
        dst[_h][_i] = S.arow(u, _h * HALF + _R); } } while (0)
#define PG8_ROWS_TO_VO(dst, src) do { _Pragma("unroll") for (int _h = 0; _h < 2; ++_h) _Pragma("unroll") for (int _i = 0; _i < 2; ++_i) { int _R, _C; stage_rc(tid * 16 + _i * 8192, _R, _C); \
        dst[_h][_i] = (unsigned)(S.fin(src[_h][_i]) * K + _C) * 2u; } } while (0)
#define PG8_LDA(dst, b, h) do { _Pragma("unroll") for (int m = 0; m < 4; ++m) { dst[m].lo = *(const LAS v4i*)(lds + PG8_SA(b, h) + aoff + m * 2048); dst[m].hi = *(const LAS v4i*)(lds + PG8_SA(b, h) + aoff + m * 2048 + 1024); } } while (0)
#define PG8_LDB(dst, b, h) do { _Pragma("unroll") for (int n = 0; n < 2; ++n) { dst[n].lo = *(const LAS v4i*)(lds + PG8_SB(b, h) + boff + n * 2048); dst[n].hi = *(const LAS v4i*)(lds + PG8_SB(b, h) + boff + n * 2048 + 1024); } } while (0)
#define PG8_MMA(ai, bj, At, Bt) do { __builtin_amdgcn_s_setprio(1); \
        if constexpr (FP8 && FP8_MODE == 2) { _Pragma("unroll") for (int m = 0; m < 4; ++m) _Pragma("unroll") for (int n = 0; n < 2; ++n) \
            asm volatile("v_mfma_scale_f32_16x16x128_f8f6f4 %0, %1, %2, %0, %3, %3 op_sel_hi:[0,0,0]" : "+v"(acc[ai][bj][m][n]) : "v"(Bt[n]), "v"(At[m]), "v"(sc1)); } \
        else if constexpr (FP8) { _Pragma("unroll") for (int m = 0; m < 4; ++m) _Pragma("unroll") for (int n = 0; n < 2; ++n) _Pragma("unroll") for (int q = 0; q < 4; ++q) { \
            const long aq = ((long)(unsigned)At[m][2 * q]) | ((long)At[m][2 * q + 1] << 32), bq = ((long)(unsigned)Bt[n][2 * q]) | ((long)Bt[n][2 * q + 1] << 32); \
            acc[ai][bj][m][n] = __builtin_amdgcn_mfma_f32_16x16x32_fp8_fp8(bq, aq, acc[ai][bj][m][n], 0, 0, 0); } } \
        else { _Pragma("unroll") for (int m = 0; m < 4; ++m) _Pragma("unroll") for (int n = 0; n < 2; ++n) { \
            const v4i a_lo = At[m].lo, a_hi = At[m].hi, b_lo = Bt[n].lo, b_hi = Bt[n].hi;     \
            acc[ai][bj][m][n] = __builtin_amdgcn_mfma_f32_16x16x32_bf16(__builtin_bit_cast(bf16x8, b_lo), __builtin_bit_cast(bf16x8, a_lo), acc[ai][bj][m][n], 0, 0, 0); \
            acc[ai][bj][m][n] = __builtin_amdgcn_mfma_f32_16x16x32_bf16(__builtin_bit_cast(bf16x8, b_hi), __builtin_bit_cast(bf16x8, a_hi), acc[ai][bj][m][n], 0, 0, 0); } } \
        __builtin_amdgcn_s_setprio(0); } while (0)
#define PG8_WAIT_V(n) asm volatile("s_waitcnt vmcnt(" #n ")" ::: "memory")
#define PG8_WAIT_L(n) asm volatile("s_waitcnt lgkmcnt(" #n ")" ::: "memory")
#define PG8_BAR __builtin_amdgcn_s_barrier()
#define PG8_SCHED __builtin_amdgcn_sched_barrier(0)
    GUnit cur, nxt; int ui = 0;
    if (!S.next(0, cur)) return;
    f32x4 acc[2][2][4][2];
#pragma unroll
    for (int a = 0; a < 2; ++a)
#pragma unroll
        for (int b = 0; b < 2; ++b)
#pragma unroll
            for (int m = 0; m < 4; ++m)
#pragma unroll
                for (int n = 0; n < 2; ++n) acc[a][b][m][n] = (f32x4){0.f, 0.f, 0.f, 0.f};
    int sc1 = 0x7F7F7F7F; asm volatile("" : "+v"(sc1));
    v8i At[4], B0[2], B1[2];
    unsigned vo[2][2];
    { int r0[2][2]; PG8_LOAD_ROWS(r0, cur); PG8_ROWS_TO_VO(vo, r0); }
    const char* ca = cur.a; const char* cB = cur.b;
    PG8_STAGE_B(PG8_SB(0, 0), cB); PG8_STAGE_B(PG8_SB(0, 1), cB + hstepB); PG8_STAGE_A(PG8_SA(0, 0), ca, 0, vo[0]); PG8_STAGE_A(PG8_SA(0, 1), ca, 0, vo[1]);
    if (wr == 1) PG8_BAR;
    PG8_WAIT_V(2); PG8_BAR;
    PG8_STAGE_B(PG8_SB(1, 0), cB + kstep); PG8_STAGE_A(PG8_SA(1, 0), ca, kstep, vo[0]); PG8_STAGE_B(PG8_SB(1, 1), cB + hstepB + kstep);
    PG8_WAIT_V(6); PG8_BAR;
    for (;;) {
        const bool has_next = S.next(ui + 1, nxt);
        const char* na = has_next ? nxt.a : ca; const char* nB = has_next ? nxt.b : cB;
        for (int t = 0; t < nt; t += 2) {
            const bool last = (t == nt - 2);
            const bool sw = last && has_next;
            const size_t k1 = (size_t)(t + 1) * kstep;
            const char* a2 = last ? na : ca; const size_t k2 = last ? (size_t)0 : (size_t)(t + 2) * kstep;
            const char* b2 = last ? nB : cB + (size_t)(t + 2) * kstep; const char* b3 = b2 + kstep;
            int nr[2][2];
            if (sw) PG8_LOAD_ROWS(nr, nxt);
            PG8_LDB(B0, 0, 0); PG8_LDB(B1, 0, 1); PG8_SCHED; PG8_LDA(At, 0, 0); PG8_STAGE_A(PG8_SA(1, 1), ca, k1, vo[1]);
            PG8_WAIT_V(8); PG8_WAIT_L(0); PG8_BAR; PG8_MMA(0, 0, At, B0); PG8_MMA(0, 1, At, B1); PG8_BAR; PG8_SCHED;
            if (sw) PG8_ROWS_TO_VO(vo, nr);
            PG8_LDA(At, 0, 1); PG8_STAGE_B(PG8_SB(0, 0), b2); PG8_STAGE_B(PG8_SB(0, 1), b2 + hstepB); PG8_STAGE_A(PG8_SA(0, 0), a2, k2, vo[0]);
            PG8_WAIT_V(8); PG8_WAIT_L(0); PG8_BAR; PG8_MMA(1, 0, At, B0); PG8_MMA(1, 1, At, B1); PG8_BAR; PG8_SCHED;
            PG8_LDB(B0, 1, 0); PG8_LDB(B1, 1, 1); PG8_SCHED; PG8_LDA(At, 1, 0); PG8_STAGE_A(PG8_SA(0, 1), a2, k2, vo[1]);
            PG8_WAIT_V(8); PG8_WAIT_L(0); PG8_BAR; PG8_MMA(0, 0, At, B0); PG8_MMA(0, 1, At, B1); PG8_BAR; PG8_SCHED;
            PG8_LDA(At, 1, 1); PG8_STAGE_B(PG8_SB(1, 0), b3); PG8_STAGE_B(PG8_SB(1, 1), b3 + hstepB); PG8_STAGE_A(PG8_SA(1, 0), a2, k2 + kstep, vo[0]);
            PG8_WAIT_V(8); PG8_WAIT_L(0); PG8_BAR; PG8_MMA(1, 0, At, B0); PG8_MMA(1, 1, At, B1); PG8_BAR; PG8_SCHED;
        }
        if constexpr (ALIGN_EPI) { if (wr == 0) PG8_BAR; }
        if constexpr (FP8) asm volatile("s_nop 15\n\ts_nop 15" ::: "memory");
        E(acc, cur, wr, wc, fr, fq);
        if (!has_next) break;
#pragma unroll
        for (int a = 0; a < 2; ++a)
#pragma unroll
            for (int b = 0; b < 2; ++b)
#pragma unroll
                for (int m = 0; m < 4; ++m)
#pragma unroll
                    for (int n = 0; n < 2; ++n) acc[a][b][m][n] = (f32x4){0.f, 0.f, 0.f, 0.f};
        cur = nxt; ca = na; cB = nB; ++ui;
        if constexpr (ALIGN_EPI) { if (wr == 1) PG8_BAR; }
    }
    PG8_WAIT_V(0);
    if constexpr (!ALIGN_EPI) { if (wr == 0) PG8_BAR; }
    PG8_BAR;
#undef PG8_SA
#undef PG8_SB
#undef PG8_STAGE_A
#undef PG8_STAGE_B
#undef PG8_LOAD_ROWS
#undef PG8_ROWS_TO_VO
#undef PG8_LDA
#undef PG8_LDB
#undef PG8_MMA
#undef PG8_WAIT_V
#undef PG8_WAIT_L
#undef PG8_BAR
#undef PG8_SCHED
}
}
using pg8::GUnit;

#define XB_TMO      128
#define XB_XCNT(j)  (256  + 64 * (j))
#define XB_XSUB(j)  (1280 + 64 * (j))
#define XB_XGEN(j)  (2304 + 64 * (j))
#define XB_TOP      3328
#define XB_TOPGEN   3392
#define XCD_BAR_WORDS 3456
#define XB_SPIN_CAP (1u << 18)
__device__ __forceinline__ unsigned xb_ld(unsigned* p)              { return __hip_atomic_load(p, __ATOMIC_RELAXED, __HIP_MEMORY_SCOPE_AGENT); }
__device__ __forceinline__ unsigned xb_add(unsigned* p, unsigned v) { return __hip_atomic_fetch_add(p, v, __ATOMIC_RELAXED, __HIP_MEMORY_SCOPE_AGENT); }
__device__ __forceinline__ unsigned xb_xcc_id() { return (unsigned)__builtin_amdgcn_s_getreg((3 << 11) | 20) & 0xFu; }
#define XB_SPIN(cond, bar) do { unsigned _sp = 0; while (cond) { __builtin_amdgcn_s_sleep(1); \
    if ((++_sp & 255u) == 0u) { if (xb_ld(&(bar)[XB_TMO])) break; if (_sp > XB_SPIN_CAP) { atomicAdd(&(bar)[XB_TMO], 1u); break; } } } } while (0)
struct XcdBarrier { unsigned* bar; unsigned x; volatile LAS unsigned* st; };
__device__ __forceinline__ XcdBarrier xcd_barrier_post(unsigned* bar, volatile LAS unsigned* st) {
    XcdBarrier b; b.bar = bar; b.x = xb_xcc_id(); b.st = st;
    if (threadIdx.x == 0) (void)xb_add(&bar[XB_XCNT(b.x)], 1u);
    return b;
}
__device__ __forceinline__ void xcd_barrier_complete(unsigned* bar, unsigned x, unsigned& nloc, unsigned& nx) {
    const unsigned G = gridDim.x * gridDim.y * gridDim.z;
    unsigned sum, cnt, mine, sp = 0u;
    for (;;) {
        sum = 0u; cnt = 0u; mine = 0u;
#pragma unroll
        for (unsigned j = 0; j < 16; ++j) { const unsigned c = xb_ld(&bar[XB_XCNT(j)]); sum += c; cnt += (c > 0u) ? 1u : 0u; mine = (j == x) ? c : mine; }
        if (sum == G) break;
        __builtin_amdgcn_s_sleep(1);
        if ((++sp & 255u) == 0u) { if (xb_ld(&bar[XB_TMO])) break; if (sp > XB_SPIN_CAP) { atomicAdd(&bar[XB_TMO], 1u); break; } }
    }
    nloc = mine > 0u ? mine : 1u; nx = cnt > 0u ? cnt : 1u;
}
__device__ __forceinline__ void xcd_barrier(const XcdBarrier& b) {
    asm volatile("s_waitcnt vmcnt(0)" ::: "memory");
    __syncthreads();
    if (threadIdx.x == 0) {
        unsigned* bar = b.bar;
        __builtin_amdgcn_s_waitcnt(0);
        unsigned nloc = b.st[0], nx = b.st[1];
        if (nloc == 0u) { xcd_barrier_complete(bar, b.x, nloc, nx); b.st[0] = nloc; b.st[1] = nx; }
        const unsigned old = xb_add(&bar[XB_XSUB(b.x)], 1u);
        const unsigned gen = old / nloc;
        if (old + 1u == (gen + 1u) * nloc) {
            __builtin_amdgcn_fence(__ATOMIC_RELEASE, "agent");
            asm volatile("s_waitcnt vmcnt(0)" ::: "memory");
            const unsigned og = xb_add(&bar[XB_TOP], 1u);
            const unsigned tg = og / nx;
            if (og + 1u == (tg + 1u) * nx) xb_add(&bar[XB_TOPGEN], 1u);
            else XB_SPIN(xb_ld(&bar[XB_TOPGEN]) == tg, bar);
            __builtin_amdgcn_fence(__ATOMIC_ACQUIRE, "agent");
            xb_add(&bar[XB_XGEN(b.x)], 1u);
            asm volatile("s_waitcnt vmcnt(0)" ::: "memory");
        } else {
            XB_SPIN(xb_ld(&bar[XB_XGEN(b.x)]) == gen, bar);
            __builtin_amdgcn_fence(__ATOMIC_ACQUIRE, "agent");
            asm volatile("s_waitcnt vmcnt(0)" ::: "memory");
        }
    }
    __syncthreads();
}

struct Args {
    const float* in[22];
    float* out; unsigned char* ws;
    int ph_lo, ph_hi;
};
struct Frame {
    LAS unsigned char* lds;
    unsigned* ctl;
    int vcu, G, bx;
    unsigned char* ws;
    const Args* A;
    float* out;
};

struct SchedWin {
    static constexpr bool GATHER = false;
    pg8::StaticMap sm; int G, c; const char* hb; const char* wmain; const char* wf;
    __device__ __forceinline__ bool next(int i, GUnit& u) const {
        int L = i * G + c; u.alist = nullptr; u.nvalid = 256;
        if (L < 768) { int pm, pn; sm.map(L, pm, pn); u.a = hb; u.arow0 = pm * 256; u.b = wmain + (size_t)pn * 256 * DM * 2; u.kind = 0; u.pm = pm; u.pn = pn; u.aux = 0; return true; }
        L -= 768; if (L >= 256) return false;
        const int b_ = L & 7, r32 = L >> 3, pm = r32 >> 1, pn = r32 & 1;
        u.a = hb; u.arow0 = pm * 256; u.b = wf + (size_t)pn * 256 * DM * 2; u.kind = 1; u.pm = pm; u.pn = pn; u.aux = b_; return true;
    }
    __device__ __forceinline__ int arow(const GUnit& u, int r) const { const int n = u.arow0 + r; return u.kind == 0 ? n : u.aux * SEQ + ((n & 63) << 6) + (n >> 6); }
    __device__ __forceinline__ int fin(int x) const { return x; }
};
struct EpiWin {
    static constexpr bool PERM = true;
    bf16* zmain; bf16* zt;
    __device__ __forceinline__ void operator()(const f32x4 (&acc)[2][2][4][2], const GUnit& u, int wr, int wc, int fr, int fq) const {
        if (u.kind == 0) {
#pragma unroll
            for (int ai = 0; ai < 2; ++ai)
#pragma unroll
                for (int m = 0; m < 4; ++m) {
                    const int rr = ai * 128 + wr * 64 + m * 16 + fr;
                    bf16* rowp = zmain + (size_t)(u.pm * 256 + rr) * NMAIN + u.pn * 256 + wc * 32 + 8 * fq;
#pragma unroll
                    for (int bj = 0; bj < 2; ++bj) { const f32x4 v0 = acc[ai][bj][m][0], v1 = acc[ai][bj][m][1];
                        u32x4 w; w.x = pg8::cvt_pk_bf16(v0[0], v0[1]); w.y = pg8::cvt_pk_bf16(v0[2], v0[3]); w.z = pg8::cvt_pk_bf16(v1[0], v1[1]); w.w = pg8::cvt_pk_bf16(v1[2], v1[3]);
                        *(u32x4*)(rowp + bj * 128) = w; }
                }
        } else {
#pragma unroll
            for (int ai = 0; ai < 2; ++ai)
#pragma unroll
                for (int m = 0; m < 4; ++m) {
                    const int s1 = m * 16 + fr, s2 = u.pm * 4 + ai * 2 + wr;
                    bf16* base = zt + ((size_t)(u.aux * 256 + wc * 32 + 8 * fq) * 64 + s2) * 128 + u.pn * 64 + s1;
                    asm volatile("" : "+v"(base));
#pragma unroll
                    for (int bj = 0; bj < 2; ++bj)
#pragma unroll
                        for (int n = 0; n < 2; ++n)
#pragma unroll
                            for (int j = 0; j < 4; ++j) { const int col = bj * 128 + 4 * n + j; base[(size_t)col * 64 * 128] = (bf16)f2bf(acc[ai][bj][m][n][j]); }
                    asm volatile("" ::: "memory");
                }
        }
    }
};
struct SchedWout {
    static constexpr bool GATHER = false;
    pg8::StaticMap sm; int G, c; const char* mix; const char* wt;
    __device__ __forceinline__ bool next(int i, GUnit& u) const {
        const int L = i * G + c; if (L >= sm.nwg) return false;
        int pm, pn; sm.map(L, pm, pn); u.a = mix; u.arow0 = pm * 256; u.b = wt + (size_t)pn * 256 * DM * 2; u.kind = 0; u.pm = pm; u.pn = pn; u.aux = 0; u.alist = nullptr; u.nvalid = 256; return true;
    }
    __device__ __forceinline__ int arow(const GUnit& u, int r) const { return u.arow0 + r; }
    __device__ __forceinline__ int fin(int x) const { return x; }
};
struct EpiWout {
    static constexpr bool PERM = false;
    const float* xsrc; float* xa; const float* gate;
    __device__ __forceinline__ void operator()(const f32x4 (&acc)[2][2][4][2], const GUnit& u, int wr, int wc, int fr, int fq) const {
        const int b_ = u.pm >> 4; const int col0 = u.pn * 256 + wc * 32 + 4 * fq;
        f32x4 gv[2][2];
#pragma unroll
        for (int bj = 0; bj < 2; ++bj)
#pragma unroll
            for (int n = 0; n < 2; ++n) gv[bj][n] = *(const f32x4*)(gate + (size_t)b_ * NMOD + col0 + bj * 128 + n * 16);
#pragma unroll
        for (int ai = 0; ai < 2; ++ai)
#pragma unroll
            for (int m = 0; m < 4; ++m) { const size_t off = (size_t)(u.pm * 256 + ai * 128 + wr * 64 + m * 16 + fr) * DM + col0;
#pragma unroll
                for (int bj = 0; bj < 2; ++bj)
#pragma unroll
                    for (int n = 0; n < 2; ++n) { const f32x4 xs = *(const f32x4*)(xsrc + off + bj * 128 + n * 16); *(f32x4*)(xa + off + bj * 128 + n * 16) = xs + gv[bj][n] * acc[ai][bj][m][n]; }
                asm volatile("" ::: "memory"); }
    }
};
struct SchedMoe {
    static constexpr bool GATHER = true;
    const volatile LAS unsigned* desc; const volatile LAS int* cnt; int nu; int which;
    const char* hb; const char* hmoe; const char* wt; const int* list;
    __device__ __forceinline__ bool next(int i, GUnit& u) const {
        if (i >= nu) return false;
        const unsigned d = (unsigned)__builtin_amdgcn_readfirstlane((int)desc[i]);
        const int e = d & 63, pn = (d >> 6) & 3, rb = (d >> 8) & 255, blk = d >> 16;
        const int ce = __builtin_amdgcn_readfirstlane(cnt[e]);
        int nv = ce - rb * 256; nv = nv > 256 ? 256 : nv;
        u.alist = list + (size_t)e * NTOK + rb * 256; u.nvalid = nv; u.kind = e; u.pm = blk; u.pn = pn; u.aux = rb; u.arow0 = blk * 256;
        if (which == 1) { u.a = hb; u.b = wt + ((size_t)e * 1024 + (size_t)pn * 256) * DM; }
        else { u.a = hmoe; u.b = wt + ((size_t)e * 1024 + (size_t)pn * 256) * DFF; }
        return true;
    }
    __device__ __forceinline__ int arow(const GUnit& u, int r) const {
        if (which == 1) return (r < u.nvalid) ? u.alist[r] : 0;
        return u.arow0 + r;
    }
    __device__ __forceinline__ int fin(int x) const { return which == 1 ? (x >> 1) : x; }
};
struct EpiMoe1 {
    static constexpr bool PERM = true;
    unsigned char* hmoe;
    __device__ __forceinline__ void operator()(const f32x4 (&acc)[2][2][4][2], const GUnit& u, int wr, int wc, int fr, int fq) const {
#pragma unroll
        for (int ai = 0; ai < 2; ++ai)
#pragma unroll
            for (int m = 0; m < 4; ++m) {
                const int rr = ai * 128 + wr * 64 + m * 16 + fr;
                unsigned char* rowp = hmoe + (size_t)(u.pm * 256 + rr) * DFF + u.pn * 128 + wc * 32 + 8 * fq;
                float hv[8];
#pragma unroll
                for (int n = 0; n < 2; ++n)
#pragma unroll
                    for (int j = 0; j < 4; ++j) { const float g = acc[ai][0][m][n][j] * (1.0f / W8_SCALE), uu = acc[ai][1][m][n][j] * (H8_SCALE / W8_SCALE); hv[n * 4 + j] = clamp448(g * sigmoidf_(g) * uu); }
                *(u32x2*)rowp = (u32x2){pk4_fp8(hv[0], hv[1], hv[2], hv[3]), pk4_fp8(hv[4], hv[5], hv[6], hv[7])};
            }
    }
};
struct EpiMoe2 {
    static constexpr bool PERM = true;
    bf16* contrib; const int* listbase; const float* gwl;
    __device__ __forceinline__ void operator()(const f32x4 (&acc)[2][2][4][2], const GUnit& u, int wr, int wc, int fr, int fq) const {
        const float* gwp = gwl + (u.alist - listbase);
#pragma unroll
        for (int ai = 0; ai < 2; ++ai)
#pragma unroll
            for (int m = 0; m < 4; ++m) {
                const int rr = ai * 128 + wr * 64 + m * 16 + fr;
                if (rr < u.nvalid) {
                    const int a = u.alist[rr]; const float g = gwp[rr] * (1.0f / (W8_SCALE * H8_SCALE));
                    bf16* rowp = contrib + (size_t)a * DM + u.pn * 256 + wc * 32 + 8 * fq;
#pragma unroll
                    for (int bj = 0; bj < 2; ++bj) { const f32x4 v0 = acc[ai][bj][m][0] * g, v1 = acc[ai][bj][m][1] * g;
                        u32x4 w; w.x = pg8::cvt_pk_bf16(v0[0], v0[1]); w.y = pg8::cvt_pk_bf16(v0[2], v0[3]); w.z = pg8::cvt_pk_bf16(v1[0], v1[1]); w.w = pg8::cvt_pk_bf16(v1[2], v1[3]);
                        *(u32x4*)(rowp + bj * 128) = w; }
                }
            }
    }
};

__device__ __forceinline__ void transpose_item(const float* W, int ldw, int col0, int k0, bf16* dst, int kdst, LAS float* scr, int lane) {
    float tv[32];
#pragma unroll
    for (int i = 0; i < 32; ++i) { const int kk = 2 * i + (lane >> 5); tv[i] = __builtin_nontemporal_load(W + (size_t)(k0 + kk) * ldw + col0 + (lane & 31)); }
#pragma unroll
    for (int i = 0; i < 32; ++i) { const int kk = 2 * i + (lane >> 5); scr[kk * 33 + (lane & 31)] = tv[i]; }
    LDS_WAIT(); asm volatile("" ::: "memory");
    const int c = lane & 7;
#pragma unroll
    for (int j = 0; j < 4; ++j) { const int n = (lane >> 3) + 8 * j; const LAS float* s = scr + (8 * c) * 33 + n;
        u32x4 o; o.x = pk2(s[0 * 33], s[1 * 33]); o.y = pk2(s[2 * 33], s[3 * 33]); o.z = pk2(s[4 * 33], s[5 * 33]); o.w = pk2(s[6 * 33], s[7 * 33]);
        *(u32x4*)(dst + (size_t)n * kdst + k0 + 8 * c) = o; }
    LDS_WAIT(); asm volatile("" ::: "memory");
}

__device__ __forceinline__ void transpose_item_f8(const float* W, int ldw, int col0, int k0, unsigned char* dst, int kdst, LAS float* scr, int lane) {
    float tv[32];
#pragma unroll
    for (int i = 0; i < 32; ++i) { const int kk = 2 * i + (lane >> 5); tv[i] = __builtin_nontemporal_load(W + (size_t)(k0 + kk) * ldw + col0 + (lane & 31)); }
#pragma unroll
    for (int i = 0; i < 32; ++i) { const int kk = 2 * i + (lane >> 5); scr[kk * 33 + (lane & 31)] = tv[i] * W8_SCALE; }
    LDS_WAIT(); asm volatile("" ::: "memory");
    const int c = lane & 7;
#pragma unroll
    for (int j = 0; j < 4; ++j) { const int n = (lane >> 3) + 8 * j; const LAS float* sp = scr + (8 * c) * 33 + n;
        *(u32x2*)(dst + (size_t)n * kdst + k0 + 8 * c) = (u32x2){pk4_fp8(sp[0 * 33], sp[1 * 33], sp[2 * 33], sp[3 * 33]), pk4_fp8(sp[4 * 33], sp[5 * 33], sp[6 * 33], sp[7 * 33])}; }
    LDS_WAIT(); asm volatile("" ::: "memory");
}

__device__ __forceinline__ void p0_prologue(Frame& F) {
    PHASE_LOCALS(F);
    float* MOD = (float*)(ws + WS_MOD);
    if (F.bx < 192) {
        LAS float* sc = (LAS float*)F.lds;
        LAS float* red = (LAS float*)(F.lds + 32768);
        const int l = F.bx / 96, cb = F.bx % 96;
        for (int i = tid; i < NB_ * DM; i += NTHREADS) { const float v = F.A->in[1][i]; sc[i] = v * sigmoidf_(v); }
        __syncthreads();
        const int col = cb * 64 + lane, ks = wave;
        float acc[8];
#pragma unroll
        for (int b = 0; b < 8; ++b) acc[b] = 0.f;
        const float* wp = F.A->in[4] + ((size_t)l * DM + (size_t)ks * 128) * NMOD + col;
#pragma unroll 8
        for (int kk = 0; kk < 128; ++kk) { const float w = wp[(size_t)kk * NMOD];
#pragma unroll
            for (int b = 0; b < 8; ++b) acc[b] += sc[b * DM + ks * 128 + kk] * w; }
#pragma unroll
        for (int b = 0; b < 8; ++b) red[(ks * 8 + b) * 64 + lane] = acc[b];
        __syncthreads();
        { const int b = wave; float s = F.A->in[5][(size_t)l * NMOD + col];
#pragma unroll
          for (int k2 = 0; k2 < 8; ++k2) s += red[(k2 * 8 + b) * 64 + lane];
          MOD[((size_t)l * 8 + b) * NMOD + col] = s; }
        __syncthreads();
    }
    const int gw = F.vcu * NWAVES + wave, NGW = F.G * NWAVES;
    const int gt = F.bx * NTHREADS + tid, NGT = F.G * NTHREADS;
    {
        bf16* ft1 = (bf16*)(ws + WS_FT1); bf16* ft2 = (bf16*)(ws + WS_FT2);
        for (int i = gt; i < 128 * 128 + 64 * 128; i += NGT) {
            if (i < 128 * 128) { const int n = i >> 7, kk = i & 127, k1 = n >> 1, pp = n & 1, p = kk >> 6, s1 = kk & 63;
                const float x = (float)((s1 * k1) & 63) * (1.0f / 32.0f); const float cs = cospif(x), sn = sinpif(x);
                const float v = pp == 0 ? (p == 0 ? cs : -sn) : (p == 0 ? sn : cs); ft1[i] = (bf16)f2bf(v); }
            else { const int q = i - 128 * 128, k2 = q >> 7, kk = q & 127, p = kk >> 6, s2 = kk & 63;
                const float x = (float)((s2 * k2) & 63) * (1.0f / 32.0f); const float v = (p == 0 ? cospif(x) : -sinpif(x)) * (1.0f / 512.0f); ft2[q] = (bf16)f2bf(v); }
        }
    }
    { bf16* sw = (bf16*)(ws + WS_SGUW);
      for (int i = gt; i < 2 * 6 * 128 * 128 / 2; i += NGT) { const f32x2 v = *(const f32x2*)(F.A->in[14] + 2 * (size_t)i); *(unsigned*)(sw + 2 * (size_t)i) = pk2(v.x, v.y); } }
    {
        LAS float* t64 = (LAS float*)(F.lds + 16384);
        if (tid < 64) t64[tid] = cospif((float)tid * (1.0f / 32.0f));
        __syncthreads();
        bf16* wf = (bf16*)(ws + WS_WINF);
        for (int it = gw; it < 2 * 4 * 16 * 2 * 4; it += NGW) {
            const int jq = it & 3, part = (it >> 2) & 1, kb = (it >> 3) & 15, g = (it >> 7) & 3, l = it >> 9;
            const int k = kb * 64 + lane;
            const float* src = F.A->in[6] + ((size_t)l * DM + k) * WIN_COLS + 768 + g * 64;
            float wv[64];
#pragma unroll
            for (int c4 = 0; c4 < 16; ++c4) { const f32x4 v = *(const f32x4*)(src + 4 * c4); wv[4 * c4] = v.x; wv[4 * c4 + 1] = v.y; wv[4 * c4 + 2] = v.z; wv[4 * c4 + 3] = v.w; }
            for (int jj = 0; jj < 16; ++jj) { const int j = jq * 16 + jj; float s = 0.f;
#pragma unroll
                for (int c = 0; c < 64; ++c) { const int t = (c * j + (part ? 48 : 0)) & 63; s += wv[c] * t64[t]; }
                wf[((size_t)l * NFOUR + part * 256 + g * 64 + j) * DM + k] = (bf16)f2bf(s); }
        }
        __syncthreads();
    }
    {
        LAS float* scr = (LAS float*)(F.lds + wave * 16384);
        constexpr int I_EXP = 2 * 64 * 3 * 256, I_WIN = 2 * 768, I_WOUT = 2 * 512, I_R = 32;
        for (int it = gw; it < I_EXP + I_WIN + I_WOUT + I_R; it += NGW) {
            int r = it;
            if (r < I_EXP) {
                const int sub = r & 255, mat = r >> 8, which = mat % 3, le = mat / 3;
                if (which < 2) { const int nb = sub & 15, kb = sub >> 4, n0 = nb * 32; const float* W = (which == 0 ? F.A->in[18] : F.A->in[19]) + (size_t)le * DM * DFF;
                    unsigned char* dst = (ws + WS_W13T) + ((size_t)le * 1024 + (n0 >> 7) * 256 + which * 128 + (n0 & 127)) * DM;
                    transpose_item_f8(W, DFF, n0, kb * 64, dst, DM, scr, lane); }
                else { const int nb = sub & 31, kb = sub >> 5, n0 = nb * 32; const float* W = F.A->in[20] + (size_t)le * DFF * DM;
                    unsigned char* dst = (ws + WS_W2T) + ((size_t)le * 1024 + n0) * DFF;
                    transpose_item_f8(W, DM, n0, kb * 64, dst, DFF, scr, lane); }
                continue; }
            r -= I_EXP;
            if (r < I_WIN) { const int l = r / 768, sub = r % 768, nb = sub % 48, kb = sub / 48, n0 = nb * 32; const int col0 = n0 < 768 ? n0 : n0 + 256;
                transpose_item(F.A->in[6] + (size_t)l * DM * WIN_COLS, WIN_COLS, col0, kb * 64, (bf16*)(ws + WS_WINT) + ((size_t)l * NMAIN + n0) * DM, DM, scr, lane); continue; }
            r -= I_WIN;
            if (r < I_WOUT) { const int l = r / 512, sub = r % 512, nb = sub & 31, kb = sub >> 5, n0 = nb * 32;
                transpose_item(F.A->in[7] + (size_t)l * DM * DM, DM, n0, kb * 64, (bf16*)(ws + WS_WOUTT) + ((size_t)l * DM + n0) * DM, DM, scr, lane); continue; }
            r -= I_WOUT;
            { const int nb = r & 1, kb = r >> 1, n0 = nb * 32;
              transpose_item(F.A->in[16], NEXP, n0, kb * 64, (bf16*)(ws + WS_ROUTERT) + (size_t)n0 * DM, DM, scr, lane); }
        }
    }
}

__device__ __forceinline__ void norm_phase(Frame& F, int mode, int l) {
    PHASE_LOCALS(F);
    const int gw = F.vcu * NWAVES + wave, NGW = F.G * NWAVES;
    const float* MOD = (const float*)(ws + WS_MOD);
    float* XA = (float*)(ws + WS_XA); bf16* HB = (bf16*)(ws + WS_HB); const bf16* CT = (const bf16*)(ws + WS_CONTRIB);
    for (int row = gw; row < NTOK; row += NGW) {
        const int b = row >> 12;
        const float* src = (mode == 0 ? F.A->in[0] : XA) + (size_t)row * DM + 4 * lane;
        f32x4 v[4];
#pragma unroll
        for (int j = 0; j < 4; ++j) v[j] = *(const f32x4*)(src + 256 * j);
        if (mode != 0) {
            const float* g2 = MOD + ((size_t)(l - 1) * 8 + b) * NMOD + 5 * DM + 4 * lane;
            const bf16* c0 = CT + (size_t)(2 * row) * DM + 4 * lane; const bf16* c1 = c0 + DM;
#pragma unroll
            for (int j = 0; j < 4; ++j) { const f32x4 g = *(const f32x4*)(g2 + 256 * j); const u32x2 a = *(const u32x2*)(c0 + 256 * j), bb = *(const u32x2*)(c1 + 256 * j);
                v[j].x += g.x * (bflo(a.x) + bflo(bb.x)); v[j].y += g.y * (bfhi(a.x) + bfhi(bb.x)); v[j].z += g.z * (bflo(a.y) + bflo(bb.y)); v[j].w += g.w * (bfhi(a.y) + bfhi(bb.y)); }
            if (mode == 1) {
#pragma unroll
                for (int j = 0; j < 4; ++j) *(f32x4*)(XA + (size_t)row * DM + 4 * lane + 256 * j) = v[j]; }
        }
        float ss = 0.f;
#pragma unroll
        for (int j = 0; j < 4; ++j) ss += (v[j].x * v[j].x + v[j].y * v[j].y) + (v[j].z * v[j].z + v[j].w * v[j].w);
        const float rs = rsqrtf(wave_sum(ss) * (1.0f / DM) + EPS);
        if (mode == 2) {
#pragma unroll
            for (int j = 0; j < 4; ++j) { const f32x4 g = *(const f32x4*)(F.A->in[21] + 4 * lane + 256 * j); *(f32x4*)(F.out + (size_t)row * DM + 4 * lane + 256 * j) = v[j] * rs * g; }
        } else {
            const float* mp = MOD + ((size_t)l * 8 + b) * NMOD + 4 * lane;
#pragma unroll
            for (int j = 0; j < 4; ++j) { const f32x4 g = *(const f32x4*)(F.A->in[2] + (size_t)l * DM + 4 * lane + 256 * j), sh = *(const f32x4*)(mp + 256 * j), scl = *(const f32x4*)(mp + DM + 256 * j);
                const f32x4 h = v[j] * rs * g * (scl + 1.0f) + sh;
                *(u32x2*)(HB + (size_t)row * DM + 4 * lane + 256 * j) = (u32x2){pk2(h.x, h.y), pk2(h.z, h.w)}; }
        }
    }
}

__device__ __forceinline__ void conv_unit(Frame& F, int l, int unit) {
    PHASE_LOCALS(F);
    const int st = unit & 31, hd = (unit >> 5) % 6, b = unit / 192, s0 = st * 128;
    const bf16* ZM = (const bf16*)(ws + WS_ZMAIN); bf16* MIX = (bf16*)(ws + WS_MIX);
    LAS float* T = (LAS float*)F.lds;
    for (int idx = tid; idx < 158 * 8; idx += NTHREADS) {
        const int row = idx >> 3, c8 = idx & 7, s = s0 - 15 + row;
        float o[8];
        if (s >= 0 && s < SEQ) {
            const bf16* p = ZM + (size_t)(b * SEQ + s) * NMAIN + hd * 64 + c8 * 8;
            const u32x4 av = *(const u32x4*)p, gv = *(const u32x4*)(p + CONVW);
            const unsigned aw[4] = {av.x, av.y, av.z, av.w}, gq[4] = {gv.x, gv.y, gv.z, gv.w};
#pragma unroll
            for (int j = 0; j < 4; ++j) { o[2 * j] = bflo(aw[j]) * sigmoidf_(bflo(gq[j])); o[2 * j + 1] = bfhi(aw[j]) * sigmoidf_(bfhi(gq[j])); }
        } else {
#pragma unroll
            for (int j = 0; j < 8; ++j) o[j] = 0.f;
        }
#pragma unroll
        for (int j = 0; j < 8; ++j) T[row * 65 + c8 * 8 + j] = o[j];
    }
    __syncthreads();
    {
        const int c = lane, p0 = wave * 16, ch = hd * 64 + c;
        float w[31];
#pragma unroll
        for (int t = 0; t < 31; ++t) w[t] = F.A->in[8][((size_t)l * 31 + t) * CONVW + ch];
        const float bias = F.A->in[9][l * CONVW + ch], gg = F.A->in[10][l * CONVW + ch], gb = F.A->in[11][l * CONVW + ch];
        float in[46];
#pragma unroll
        for (int j = 0; j < 46; ++j) in[j] = T[(p0 + j) * 65 + c];
#pragma unroll
        for (int i = 0; i < 16; ++i) {
            float a = bias;
#pragma unroll
            for (int t = 0; t < 31; ++t) a += w[t] * in[i + t];
            const float mean = wave_sum(a) * (1.0f / 64.0f), d = a - mean;
            const float var = wave_sum(d * d) * (1.0f / 64.0f);
            float y = d * rsqrtf(var + EPS) * gg + gb; y = y * sigmoidf_(y);
            MIX[(size_t)(b * SEQ + s0 + p0 + i) * DM + ch] = (bf16)f2bf(y);
        }
    }
    __syncthreads();
}

__device__ __forceinline__ void sgu_unit(Frame& F, int l, int unit) {
    PHASE_LOCALS(F);
    const int b = unit >> 5, s0 = (unit & 31) * 128;
    const bf16* ZM = (const bf16*)(ws + WS_ZMAIN); bf16* MIX = (bf16*)(ws + WS_MIX); const bf16* SW = (const bf16*)(ws + WS_SGUW);
    LAS bf16* vT = (LAS bf16*)F.lds;
    constexpr int VP = 136;
    for (int grp = 0; grp < 2; ++grp) {
        const int q0 = wave * 16 + grp * 8;
        float val[8][6];
#pragma unroll
        for (int i = 0; i < 8; ++i) {
            const bf16* p = ZM + (size_t)(b * SEQ + s0 + q0 + i) * NMAIN + 1152 + 2 * lane;
#pragma unroll
            for (int j = 0; j < 3; ++j) { const unsigned wv = *(const unsigned*)(p + 128 * j); val[i][2 * j] = gelu_tanh(bflo(wv)); val[i][2 * j + 1] = gelu_tanh(bfhi(wv)); }
        }
        float lg[6], lb[6];
#pragma unroll
        for (int j = 0; j < 3; ++j) { const f32x2 g = *(const f32x2*)(F.A->in[12] + l * SGUW_ + 2 * lane + 128 * j), bb = *(const f32x2*)(F.A->in[13] + l * SGUW_ + 2 * lane + 128 * j); lg[2 * j] = g.x; lg[2 * j + 1] = g.y; lb[2 * j] = bb.x; lb[2 * j + 1] = bb.y; }
#pragma unroll
        for (int i = 0; i < 8; ++i) {
            float s = 0.f;
#pragma unroll
            for (int j = 0; j < 6; ++j) s += val[i][j];
            const float mean = wave_sum(s) * (1.0f / 384.0f); float q = 0.f;
#pragma unroll
            for (int j = 0; j < 6; ++j) { val[i][j] -= mean; q += val[i][j] * val[i][j]; }
            const float rstd = rsqrtf(wave_sum(q) * (1.0f / 384.0f) + EPS);
#pragma unroll
            for (int j = 0; j < 6; ++j) val[i][j] = val[i][j] * rstd * lg[j] + lb[j];
        }
#pragma unroll
        for (int j = 0; j < 6; ++j) { const int ch = 2 * lane + 128 * (j >> 1) + (j & 1);
            u32x4 o; o.x = pk2(val[0][j], val[1][j]); o.y = pk2(val[2][j], val[3][j]); o.z = pk2(val[4][j], val[5][j]); o.w = pk2(val[6][j], val[7][j]);
            *(LAS u32x4*)(vT + ch * VP + q0) = o; }
    }
    __syncthreads();
    {
        const int fr = lane & 15, fq = lane >> 4;
        for (int st = wave; st < 24; st += 8) {
            const int h = st >> 2, p0 = (st & 3) * 32;
            f32x4 acc[2][4];
#pragma unroll
            for (int mi = 0; mi < 2; ++mi)
#pragma unroll
                for (int ni = 0; ni < 4; ++ni) acc[mi][ni] = (f32x4){0.f, 0.f, 0.f, 0.f};
#pragma unroll
            for (int ks = 0; ks < 4; ++ks) {
                bf16x8 af[2], bfr[4];
#pragma unroll
                for (int mi = 0; mi < 2; ++mi) af[mi] = *(const bf16x8*)(SW + ((size_t)(l * 6 + h) * 128 + p0 + 16 * mi + fr) * 128 + ks * 32 + fq * 8);
#pragma unroll
                for (int ni = 0; ni < 4; ++ni) bfr[ni] = *(const LAS bf16x8*)(vT + (h * 64 + 16 * ni + fr) * VP + ks * 32 + fq * 8);
#pragma unroll
                for (int mi = 0; mi < 2; ++mi)
#pragma unroll
                    for (int ni = 0; ni < 4; ++ni) acc[mi][ni] = __builtin_amdgcn_mfma_f32_16x16x32_bf16(bfr[ni], af[mi], acc[mi][ni], 0, 0, 0);
            }
#pragma unroll
            for (int mi = 0; mi < 2; ++mi) {
                const int p = p0 + 16 * mi + fr; const float bias = F.A->in[15][(size_t)(l * 6 + h) * 128 + p];
                const size_t tok = (size_t)(b * SEQ + s0 + p);
#pragma unroll
                for (int ni = 0; ni < 4; ++ni) {
                    const int d = 16 * ni + 4 * fq;
                    const u32x2 uv = *(const u32x2*)(ZM + tok * NMAIN + 768 + h * 64 + d);
                    const float o0 = gelu_tanh(bflo(uv.x)) * (acc[mi][ni][0] + bias), o1 = gelu_tanh(bfhi(uv.x)) * (acc[mi][ni][1] + bias);
                    const float o2 = gelu_tanh(bflo(uv.y)) * (acc[mi][ni][2] + bias), o3 = gelu_tanh(bfhi(uv.y)) * (acc[mi][ni][3] + bias);
                    *(u32x2*)(MIX + tok * DM + 640 + h * 64 + d) = (u32x2){pk2(o0, o1), pk2(o2, o3)};
                }
            }
        }
    }
    __syncthreads();
}

__device__ __forceinline__ void dft_stage1(Frame& F) {
    PHASE_LOCALS(F);
    const int fr = lane & 15, fq = lane >> 4;
    const bf16* ZT = (const bf16*)(ws + WS_ZT); bf16* TG = (bf16*)(ws + WS_TG); const bf16* FT1 = (const bf16*)(ws + WS_FT1);
    bf16x8 bfr[8][4];
#pragma unroll
    for (int ni = 0; ni < 8; ++ni)
#pragma unroll
        for (int ks = 0; ks < 4; ++ks) bfr[ni][ks] = *(const bf16x8*)(FT1 + (16 * ni + fr) * 128 + ks * 32 + fq * 8);
    const int gw = F.vcu * NWAVES + wave, NGW = F.G * NWAVES;
    for (int mt = gw; mt < NB_ * FOURW * 64 / 16; mt += NGW) {
        const int row = mt * 16 + fr;
        bf16x8 a[4];
#pragma unroll
        for (int ks = 0; ks < 4; ++ks) a[ks] = *(const bf16x8*)(ZT + (size_t)row * 128 + ks * 32 + fq * 8);
        f32x4 acc[8];
#pragma unroll
        for (int ni = 0; ni < 8; ++ni) acc[ni] = (f32x4){0.f, 0.f, 0.f, 0.f};
#pragma unroll
        for (int ks = 0; ks < 4; ++ks)
#pragma unroll
            for (int ni = 0; ni < 8; ++ni) acc[ni] = __builtin_amdgcn_mfma_f32_16x16x32_bf16(bfr[ni][ks], a[ks], acc[ni], 0, 0, 0);
        const int s2 = row & 63, col = (row >> 6) & 255, b = row >> 14;
#pragma unroll
        for (int ni = 0; ni < 8; ++ni)
#pragma unroll
            for (int h = 0; h < 2; ++h) {
                const int k1 = 8 * ni + 2 * fq + h; const float re = acc[ni][2 * h], im = acc[ni][2 * h + 1];
                const float x = (float)(s2 * k1) * (1.0f / 4096.0f); const float c = __builtin_amdgcn_cosf(x), sn = __builtin_amdgcn_sinf(x);
                bf16* dst = TG + ((size_t)((b * 64 + k1) * 256 + col)) * 128 + s2;
                dst[0] = (bf16)f2bf(c * re - sn * im); dst[64] = (bf16)f2bf(sn * re + c * im);
            }
    }
}
__device__ __forceinline__ void dft_stage2(Frame& F) {
    PHASE_LOCALS(F);
    const int fr = lane & 15, fq = lane >> 4;
    const bf16* TG = (const bf16*)(ws + WS_TG); bf16* MIX = (bf16*)(ws + WS_MIX); const bf16* FT2 = (const bf16*)(ws + WS_FT2);
    bf16x8 bfr[4][4];
#pragma unroll
    for (int ni = 0; ni < 4; ++ni)
#pragma unroll
        for (int ks = 0; ks < 4; ++ks) bfr[ni][ks] = *(const bf16x8*)(FT2 + (16 * ni + fr) * 128 + ks * 32 + fq * 8);
    const int gw = F.vcu * NWAVES + wave, NGW = F.G * NWAVES;
    for (int mt = gw; mt < NB_ * FOURW * 64 / 16; mt += NGW) {
        const int row = mt * 16 + fr;
        bf16x8 a[4];
#pragma unroll
        for (int ks = 0; ks < 4; ++ks) a[ks] = *(const bf16x8*)(TG + (size_t)row * 128 + ks * 32 + fq * 8);
        f32x4 acc[4];
#pragma unroll
        for (int ni = 0; ni < 4; ++ni) acc[ni] = (f32x4){0.f, 0.f, 0.f, 0.f};
#pragma unroll
        for (int ks = 0; ks < 4; ++ks)
#pragma unroll
            for (int ni = 0; ni < 4; ++ni) acc[ni] = __builtin_amdgcn_mfma_f32_16x16x32_bf16(bfr[ni][ks], a[ks], acc[ni], 0, 0, 0);
        const int col = row & 255, k1 = (row >> 8) & 63, b = row >> 14;
#pragma unroll
        for (int ni = 0; ni < 4; ++ni)
#pragma unroll
            for (int j = 0; j < 4; ++j) { const int k2 = 16 * ni + 4 * fq + j;
                MIX[(size_t)(b * SEQ + k1 + 64 * k2) * DM + CONVW + col] = (bf16)f2bf(acc[ni][j]); }
    }
}

__device__ __forceinline__ void router_phase(Frame& F, int l) {
    PHASE_LOCALS(F);
    const float* MOD = (const float*)(ws + WS_MOD);
    const float* XA = (const float*)(ws + WS_XA); bf16* HB = (bf16*)(ws + WS_HB); const bf16* RT = (const bf16*)(ws + WS_ROUTERT);
    int* LIST = (int*)(ws + WS_LIST); float* GWL = (float*)(ws + WS_GWL); unsigned char* H8 = ws + WS_H8;
    LAS float* LG = (LAS float*)F.lds;
    LAS int* hist = (LAS int*)(F.lds + 33280);
    LAS int* hbase = (LAS int*)(F.lds + 33280 + 256);
    LAS int* sel_e = (LAS int*)(F.lds + 33280 + 512);
    LAS int* sel_p = (LAS int*)(F.lds + 33280 + 512 + 1024);
    LAS float* sel_w = (LAS float*)(F.lds + 33280 + 512 + 2048);
    for (int blk = F.bx; blk < NTOK / 128; blk += F.G) {
        const int rowbase = blk * 128, b = rowbase >> 12;
        if (tid < 64) hist[tid] = 0;
        for (int i = 0; i < 16; ++i) {
            const int row = rowbase + wave * 16 + i;
            const float* src = XA + (size_t)row * DM + 4 * lane;
            f32x4 v[4]; float ss = 0.f;
#pragma unroll
            for (int j = 0; j < 4; ++j) { v[j] = *(const f32x4*)(src + 256 * j); ss += (v[j].x * v[j].x + v[j].y * v[j].y) + (v[j].z * v[j].z + v[j].w * v[j].w); }
            const float rs = rsqrtf(wave_sum(ss) * (1.0f / DM) + EPS);
            const float* mp = MOD + ((size_t)l * 8 + b) * NMOD + 3 * DM + 4 * lane;
#pragma unroll
            for (int j = 0; j < 4; ++j) { const f32x4 g = *(const f32x4*)(F.A->in[3] + (size_t)l * DM + 4 * lane + 256 * j), sh = *(const f32x4*)(mp + 256 * j), scl = *(const f32x4*)(mp + DM + 256 * j);
                const f32x4 h = v[j] * rs * g * (scl + 1.0f) + sh;
                *(u32x2*)(HB + (size_t)row * DM + 4 * lane + 256 * j) = (u32x2){pk2(h.x, h.y), pk2(h.z, h.w)};
                *(unsigned*)(H8 + (size_t)row * DM + 4 * lane + 256 * j) = pk4_fp8(clamp448(h.x), clamp448(h.y), clamp448(h.z), clamp448(h.w)); }
        }
        VM_WAIT(); __syncthreads();
        {
            const int fr = lane & 15, fq = lane >> 4; const int row = rowbase + wave * 16 + fr;
            f32x4 acc[4];
#pragma unroll
            for (int ni = 0; ni < 4; ++ni) acc[ni] = (f32x4){0.f, 0.f, 0.f, 0.f};
#pragma unroll 4
            for (int ks = 0; ks < 32; ++ks) {
                const bf16x8 a = *(const bf16x8*)(HB + (size_t)row * DM + ks * 32 + fq * 8);
#pragma unroll
                for (int ni = 0; ni < 4; ++ni) { const bf16x8 bb = *(const bf16x8*)(RT + (size_t)(16 * ni + fr) * DM + ks * 32 + fq * 8); acc[ni] = __builtin_amdgcn_mfma_f32_16x16x32_bf16(bb, a, acc[ni], 0, 0, 0); }
            }
#pragma unroll
            for (int ni = 0; ni < 4; ++ni)
#pragma unroll
                for (int j = 0; j < 4; ++j) LG[(wave * 16 + fr) * 65 + 16 * ni + 4 * fq + j] = acc[ni][j];
        }
        __syncthreads();
        if (lane < 16) {
            const int r = wave * 16 + lane; const LAS float* lg = LG + r * 65;
            float mx = lg[0];
            for (int e = 1; e < 64; ++e) mx = fmaxf(mx, lg[e]);
            float sum = 0.f;
            for (int e = 0; e < 64; ++e) sum += __expf(lg[e] - mx);
            const float inv = 1.0f / sum;
            float best = -1e30f; int bg = 0;
            for (int g = 0; g < 8; ++g) {
                float v1 = -1e30f, v2 = -1e30f;
                for (int i = 0; i < 8; ++i) { const float sv = __expf(lg[g * 8 + i] - mx) * inv + F.A->in[17][g * 8 + i]; if (sv > v1) { v2 = v1; v1 = sv; } else if (sv > v2) v2 = sv; }
                const float gs = v1 + v2; if (gs > best) { best = gs; bg = g; }
            }
            float v1 = -1e30f, v2 = -1e30f; int i1 = 0, i2 = 0;
            for (int i = 0; i < 8; ++i) { const float sv = __expf(lg[bg * 8 + i] - mx) * inv + F.A->in[17][bg * 8 + i];
                if (sv > v1) { v2 = v1; i2 = i1; v1 = sv; i1 = i; } else if (sv > v2) { v2 = sv; i2 = i; } }
            const int e0 = bg * 8 + i1, e1 = bg * 8 + i2;
            const float p0 = __expf(lg[e0] - mx) * inv, p1 = __expf(lg[e1] - mx) * inv, den = 1.0f / (p0 + p1);
            sel_e[2 * r] = e0; sel_e[2 * r + 1] = e1; sel_w[2 * r] = p0 * den; sel_w[2 * r + 1] = p1 * den;
            sel_p[2 * r] = atomicAdd((int*)&hist[e0], 1); sel_p[2 * r + 1] = atomicAdd((int*)&hist[e1], 1);
        }
        __syncthreads();
        if (tid < 64) { const int cn = hist[tid]; hbase[tid] = cn ? (int)atomicAdd(F.ctl + CW_CNT + (l * 64 + tid) * 16, (unsigned)cn) : 0; }
        __syncthreads();
        if (tid < 256) { const int r = tid >> 1, k = tid & 1, e = sel_e[tid], slot = hbase[e] + sel_p[tid], a = (rowbase + r) * 2 + k;
            LIST[(size_t)e * NTOK + slot] = a; GWL[(size_t)e * NTOK + slot] = sel_w[tid]; }
        __syncthreads();
    }
}

__device__ __forceinline__ int moe_setup(Frame& F, int l) {
    PHASE_LOCALS(F);
    volatile LAS int* cnt = (volatile LAS int*)(F.lds + MISC_OFF + M_CNT);
    volatile LAS int* pre = (volatile LAS int*)(F.lds + MISC_OFF + M_PRE);
    volatile LAS unsigned* desc = (volatile LAS unsigned*)(F.lds + MISC_OFF + M_DESC);
    volatile LAS int* nu = (volatile LAS int*)(F.lds + MISC_OFF + M_NU);
    if (tid < 64) cnt[tid] = (int)F.ctl[CW_CNT + (l * 64 + tid) * 16];
    __syncthreads();
    if (tid == 0) {
        int p = 0;
        for (int e = 0; e < 64; ++e) { pre[e] = p; p += (cnt[e] + 255) >> 8; }
        pre[64] = p;
        int n = 0, e = 0;
        for (int L = F.vcu; L < p * 4 && n < 30; L += F.G) { const int blk = L >> 2, pn = L & 3; while (pre[e + 1] <= blk) ++e; desc[n++] = (unsigned)e | ((unsigned)pn << 6) | ((unsigned)(blk - pre[e]) << 8) | ((unsigned)blk << 16); }
        nu[0] = n;
    }
    __syncthreads();
    return __builtin_amdgcn_readfirstlane(nu[0]);
}


#ifndef DBG_CHECK
#define DBG_CHECK 0
#endif
__device__ __forceinline__ float dec8(unsigned b) { b &= 0xff; const unsigned e = (b >> 3) & 15, m = b & 7; const float v = e == 0 ? (float)m * (1.0f / 512.0f) : (float)(8 + m) * __builtin_amdgcn_ldexpf(1.0f, (int)e - 10); return (b & 0x80) ? -v : v; }
__device__ __forceinline__ unsigned hash32(unsigned i) { i *= 2654435761u; i ^= i >> 15; i *= 2246822519u; i ^= i >> 13; i *= 3266489917u; i ^= i >> 16; return i; }
__device__ __forceinline__ void dbg_fail(Frame& F, int k) { atomicMin(F.ctl + CW_CHK, (unsigned)k); }

__device__ __forceinline__ void dbg_check_win(Frame& F, int l) {
    PHASE_LOCALS(F);
    const unsigned gt = F.bx * NTHREADS + tid;
    if (gt < 16384u) { const unsigned h = hash32(gt + 12345u); const int row = h & 32767, col = (h >> 15) % 1536;
        const bf16* HB = (const bf16*)(ws + WS_HB) + (size_t)row * DM; const bf16* WT = (const bf16*)(ws + WS_WINT) + ((size_t)l * NMAIN + col) * DM;
        float s = 0.f, sa = 0.f; for (int k = 0; k < DM; ++k) { const float p = bf2f(HB[k]) * bf2f(WT[k]); s += p; sa += fabsf(p); }
        const float got = bf2f(((const bf16*)(ws + WS_ZMAIN))[(size_t)row * NMAIN + col]);
        if (fabsf(got - s) > 0.01f * fabsf(s) + 1e-3f * sa + 1e-4f) dbg_fail(F, 6); }
}
__device__ __forceinline__ void dbg_check_wout(Frame& F, int l) {
    PHASE_LOCALS(F);
    const unsigned gt = F.bx * NTHREADS + tid;
    if (gt < 16384u) { const unsigned h = hash32(gt + 54321u); const int row = h & 32767, col = (h >> 15) & 1023;
        const bf16* MX = (const bf16*)(ws + WS_MIX) + (size_t)row * DM; const bf16* WT = (const bf16*)(ws + WS_WOUTT) + ((size_t)l * DM + col) * DM;
        float s = 0.f, sa = 0.f; for (int k = 0; k < DM; ++k) { const float p = bf2f(MX[k]) * bf2f(WT[k]); s += p; sa += fabsf(p); }
        const float gate = ((const float*)(ws + WS_MOD))[((size_t)l * 8 + (row >> 12)) * NMOD + 2 * DM + col];
        const float want = F.A->in[0][(size_t)row * DM + col] + gate * s, got = ((const float*)(ws + WS_XA))[(size_t)row * DM + col];
        if (fabsf(got - want) > 1e-3f * (fabsf(gate) * sa + fabsf(want)) + 1e-4f) dbg_fail(F, 7); }
}
__device__ __forceinline__ void dbg_checks(Frame& F) {
    PHASE_LOCALS(F);
    const int l = 1;
    const unsigned gt = F.bx * NTHREADS + tid;
    const unsigned char* W13 = ws + WS_W13T; const unsigned char* W2 = ws + WS_W2T; const unsigned char* H8 = ws + WS_H8; const unsigned char* HM = ws + WS_ZMAIN;
    const bf16* HB = (const bf16*)(ws + WS_HB); const bf16* CT = (const bf16*)(ws + WS_CONTRIB); const int* LIST = (const int*)(ws + WS_LIST); const float* GWL = (const float*)(ws + WS_GWL);
    if (gt < 65536u) {
        const unsigned h = hash32(gt);
        { const int le = h & 127, which = (h >> 7) & 1, n = (h >> 8) & 511, k = (h >> 17) & 1023;
          const float w = (which ? F.A->in[19] : F.A->in[18])[((size_t)le * DM + k) * DFF + n] * W8_SCALE;
          const unsigned want = pk4_fp8(w, 0.f, 0.f, 0.f) & 0xff, got = W13[((size_t)le * 1024 + (n >> 7) * 256 + which * 128 + (n & 127)) * DM + k];
          if (want != got) dbg_fail(F, 1); }
        { const int le = h & 127, n = (h >> 7) & 1023, k = (h >> 17) & 511;
          const float w = F.A->in[20][((size_t)le * DFF + k) * DM + n] * W8_SCALE;
          const unsigned want = pk4_fp8(w, 0.f, 0.f, 0.f) & 0xff, got = W2[((size_t)le * 1024 + n) * DFF + k];
          if (want != got) dbg_fail(F, 2); }
        { const int row = h & 32767, c = (h >> 15) & 1023; const float a = bf2f(HB[(size_t)row * DM + c]), b = dec8(H8[(size_t)row * DM + c]);
          if (fabsf(a - b) > 0.07f * fabsf(a) + 0.002f) dbg_fail(F, 3); }
    }
    if (gt < 4096u) {
        const unsigned h = hash32(gt + 99991u);
        const int e = h & 63; const int cnt = (int)F.ctl[CW_CNT + (l * 64 + e) * 16];
        int pre = 0; for (int q = 0; q < e; ++q) pre += ((int)F.ctl[CW_CNT + (l * 64 + q) * 16] + 255) >> 8;
        if (cnt > 0) {
            const int p = (int)((h >> 6) % (unsigned)cnt), a = LIST[(size_t)e * NTOK + p], tok = a >> 1; const size_t prow = (size_t)pre * 256 + p;
            { const int c = (h >> 20) & 511; float g = 0.f, u = 0.f;
              const unsigned char* w1r = W13 + (((size_t)(l * 64 + e)) * 1024 + (c >> 7) * 256 + (c & 127)) * DM; const unsigned char* w3r = w1r + 128 * DM;
              for (int k = 0; k < DM; ++k) { const float x = dec8(H8[(size_t)tok * DM + k]); g += x * dec8(w1r[k]); u += x * dec8(w3r[k]); }
              g *= 1.0f / W8_SCALE; u *= 1.0f / W8_SCALE; const float want = g * sigmoidf_(g) * u * H8_SCALE, got = dec8(HM[prow * DFF + c]);
              if (fabsf(want - got) > 0.08f * fabsf(want) + 0.01f) dbg_fail(F, 4); }
            { const int c = (h >> 12) & 1023; float y = 0.f; const unsigned char* w2r = W2 + (((size_t)(l * 64 + e)) * 1024 + c) * DFF;
              for (int k = 0; k < DFF; ++k) y += dec8(HM[prow * DFF + k]) * dec8(w2r[k]);
              const float want = y * GWL[(size_t)e * NTOK + p] * (1.0f / (W8_SCALE * H8_SCALE)), got = bf2f(CT[(size_t)a * DM + c]);
              if (fabsf(want - got) > 0.02f * fabsf(want) + 0.002f) dbg_fail(F, 5); }
        }
    }
}

constexpr int N_PHASES = 18;
__global__ void __launch_bounds__(NTHREADS, 2) fwd_kernel(Args args) {
    extern __shared__ __attribute__((aligned(16))) unsigned char lds_raw[];
    Frame F;
    F.lds = (LAS unsigned char*)lds_raw;
    F.G = gridDim.x; F.bx = blockIdx.x; F.vcu = (F.G % 8 == 0) ? (F.bx % 8) * (F.G / 8) + F.bx / 8 : F.bx;
    F.ws = args.ws; F.ctl = (unsigned*)(args.ws + WS_CTL); F.out = args.out;
    F.A = &args;
    for (int u = threadIdx.x; u < (LDS_BYTES - MISC_OFF) / 4; u += NTHREADS) ((LAS unsigned*)(F.lds + MISC_OFF))[u] = 0u;
    __syncthreads();
    XcdBarrier bar; bar.bar = F.ctl + CW_BAR; bar.x = 0; bar.st = nullptr;
    if (!MK_PER_PHASE) bar = xcd_barrier_post(F.ctl + CW_BAR, (volatile LAS unsigned*)(F.lds + MISC_OFF + M_BAR));
    const int lo = args.ph_lo, hi = args.ph_hi;
#if DBG_CHECK
    if (blockIdx.x == 0 && threadIdx.x == 0) __hip_atomic_store(F.ctl + CW_CHK, 0xFFFFFFFFu, RLX_AGENT);
#endif
#define IN(k) (lo <= (k) && (k) < hi)
#define GRID_BAR() do { if (!MK_PER_PHASE) xcd_barrier(bar); } while (0)

    if (IN(0)) { for (int rep = 0; rep < REPS(0); ++rep) { p0_prologue(F); GRID_BAR(); } }

    for (int l = 0; l < 2; ++l) {
        const int pb = 1 + 8 * l;
        if (IN(pb + 0)) { for (int rep = 0; rep < (l == 0 ? REPS(1) : 1); ++rep) { norm_phase(F, l == 0 ? 0 : 1, l); GRID_BAR(); } }
        if (IN(pb + 1)) { for (int rep = 0; rep < REPS(2); ++rep) {
            PHASE_LOCALS(F);
            SchedWin S; S.sm.init(NTOK, NMAIN); S.G = F.G; S.c = F.bx; S.hb = (const char*)(ws + WS_HB);
            S.wmain = (const char*)(ws + WS_WINT) + (size_t)l * NMAIN * DM * 2; S.wf = (const char*)(ws + WS_WINF) + (size_t)l * NFOUR * DM * 2;
            EpiWin E{(bf16*)(ws + WS_ZMAIN), (bf16*)(ws + WS_ZT)};
            pg8::gemm_phase<EpiWin, SchedWin, true>(F.lds, DM, S, E);
            GRID_BAR(); }
#if DBG_CHECK
            if (l == 0) { dbg_check_win(F, l); GRID_BAR(); }
#endif
        }
        if (IN(pb + 2)) { for (int rep = 0; rep < REPS(3); ++rep) {
            for (int r2 = 0; r2 < REPS(11); ++r2) dft_stage1(F);
            for (int r2 = 0; r2 < REPS(9); ++r2) for (int u = F.vcu; u < 1536; u += F.G) conv_unit(F, l, u);
            for (int r2 = 0; r2 < REPS(10); ++r2) for (int u = F.vcu; u < 256; u += F.G) sgu_unit(F, l, u);
            GRID_BAR(); }
        }
        if (IN(pb + 3)) { for (int rep = 0; rep < REPS(5); ++rep) { dft_stage2(F); GRID_BAR(); } }
        if (IN(pb + 4)) { for (int rep = 0; rep < (l == 0 ? REPS(4) : 1); ++rep) {
            PHASE_LOCALS(F);
            SchedWout S; S.sm.init(NTOK, DM); S.G = F.G; S.c = F.bx; S.mix = (const char*)(ws + WS_MIX); S.wt = (const char*)(ws + WS_WOUTT) + (size_t)l * DM * DM * 2;
            EpiWout E{l == 0 ? F.A->in[0] : (const float*)(ws + WS_XA), (float*)(ws + WS_XA), (const float*)(ws + WS_MOD) + (size_t)l * 8 * NMOD + 2 * DM};
            pg8::gemm_phase<EpiWout, SchedWout, true>(F.lds, DM, S, E);
            GRID_BAR(); }
#if DBG_CHECK
            if (l == 0) { dbg_check_wout(F, l); GRID_BAR(); }
#endif
        }
        if (IN(pb + 5)) { router_phase(F, l); GRID_BAR(); }
        if (IN(pb + 6)) { for (int rep = 0; rep < REPS(6); ++rep) {
            PHASE_LOCALS(F);
            const int nu = moe_setup(F, l);
            SchedMoe S; S.desc = (const volatile LAS unsigned*)(F.lds + MISC_OFF + M_DESC); S.cnt = (const volatile LAS int*)(F.lds + MISC_OFF + M_CNT); S.nu = nu; S.which = 1;
            S.hb = (const char*)(ws + WS_H8); S.hmoe = (const char*)(ws + WS_ZMAIN); S.wt = (const char*)(ws + WS_W13T) + (size_t)l * 64 * 1024 * DM; S.list = (const int*)(ws + WS_LIST);
            EpiMoe1 E{ws + WS_ZMAIN};
            pg8::gemm_phase<EpiMoe1, SchedMoe, true, true>(F.lds, DM / 2, S, E);
            GRID_BAR(); }
        }
        if (IN(pb + 7)) { for (int rep = 0; rep < REPS(7); ++rep) {
            PHASE_LOCALS(F);
            const int nu = moe_setup(F, l);
            SchedMoe S; S.desc = (const volatile LAS unsigned*)(F.lds + MISC_OFF + M_DESC); S.cnt = (const volatile LAS int*)(F.lds + MISC_OFF + M_CNT); S.nu = nu; S.which = 2;
            S.hb = (const char*)(ws + WS_H8); S.hmoe = (const char*)(ws + WS_ZMAIN); S.wt = (const char*)(ws + WS_W2T) + (size_t)l * 64 * 1024 * DFF; S.list = (const int*)(ws + WS_LIST);
            EpiMoe2 E{(bf16*)(ws + WS_CONTRIB), (const int*)(ws + WS_LIST), (const float*)(ws + WS_GWL)};
            pg8::gemm_phase<EpiMoe2, SchedMoe, true, true>(F.lds, DFF / 2, S, E);
            GRID_BAR(); }
        }
    }
    if (IN(17)) {
        for (int rep = 0; rep < REPS(8); ++rep) norm_phase(F, 2, 2);
#if DBG_CHECK
        xcd_barrier(bar);
#endif
        if (!MK_PER_PHASE) {
            if (xb_ld(F.ctl + CW_BAR + XB_TMO) != 0u) { VM_WAIT(); __syncthreads(); const float q = __builtin_nanf("");
                for (size_t i = (size_t)F.bx * NTHREADS + threadIdx.x; i < (size_t)NTOK * DM; i += (size_t)F.G * NTHREADS) F.out[i] = q; }
        }
    }
#if DBG_CHECK
    if (IN(17)) {
        dbg_checks(F); xcd_barrier(bar);
        const unsigned code = xb_ld(F.ctl + CW_CHK);
        if (code != 0xFFFFFFFFu) { const float q = 1000.0f * (float)code; for (size_t i = (size_t)F.bx * NTHREADS + threadIdx.x; i < (size_t)NTOK * DM; i += (size_t)F.G * NTHREADS) F.out[i] = q; }
    }
#endif
#undef IN
#undef GRID_BAR
}

extern "C" void kernel_launch(void* const* d_in, const int* in_sizes, int n_in, void* d_out, int out_size, void* d_ws, size_t ws_size, hipStream_t stream) {
    static int grid = 0;
    if (grid == 0) {
        if (n_in != 22 || out_size != NTOK * DM || ws_size < WS_END) { fprintf(stderr, "kernel_launch: unexpected shapes (n_in %d, out %d, ws %zu, need %zu)\n", n_in, out_size, ws_size, (size_t)WS_END); grid = -1; return; }
        int dev = 0, cus = 0, per_cu = 0;
        if (hipGetDevice(&dev) != hipSuccess || hipDeviceGetAttribute(&cus, hipDeviceAttributeMultiprocessorCount, dev) != hipSuccess) { grid = -1; return; }
        if (hipFuncSetAttribute((const void*)fwd_kernel, hipFuncAttributeMaxDynamicSharedMemorySize, LDS_BYTES) != hipSuccess) { fprintf(stderr, "kernel_launch: hipFuncSetAttribute failed\n"); grid = -1; return; }
        if (hipOccupancyMaxActiveBlocksPerMultiprocessor(&per_cu, (const void*)fwd_kernel, NTHREADS, LDS_BYTES) != hipSuccess || per_cu < 1) fprintf(stderr, "kernel_launch: occupancy query says %d\n", per_cu);
        (void)hipGetLastError();
        grid = cus;
        if (grid != 256) fprintf(stderr, "kernel_launch: %d CUs (built for 256)\n", grid);
    }
    if (grid < 0) return;
    (void)hipMemsetAsync((char*)d_ws + WS_CTL, 0, CTL_ZERO_BYTES, stream);
    Args a{};
    for (int i = 0; i < 22; ++i) a.in[i] = (const float*)d_in[i];
    a.out = (float*)d_out; a.ws = (unsigned char*)d_ws;
#if MK_PER_PHASE
    for (int p = 0; p < N_PHASES; ++p) { a.ph_lo = p; a.ph_hi = p + 1; hipLaunchKernelGGL(fwd_kernel, dim3(grid), dim3(NTHREADS), LDS_BYTES, stream, a); }
#else
    a.ph_lo = 0; a.ph_hi = N_PHASES;
    hipLaunchKernelGGL(fwd_kernel, dim3(grid), dim3(NTHREADS), LDS_BYTES, stream, a);
#endif
}
```

```cpp
#include <hip/hip_runtime.h>
#include <cstdio>
#include <cstdint>

#ifndef MK_PER_PHASE
#define MK_PER_PHASE 0
#endif
#ifndef PHMASK
#define PHMASK 0xFFFF
#endif
#define PHON(k) (((PHMASK) >> (k)) & 1)
#ifndef FP8_MODE
#define FP8_MODE 2
#endif
#ifndef PROBE_REP
#define PROBE_REP -1
#endif
#define REPS(k) ((PROBE_REP) == (k) ? 2 : 1)

#define LAS __attribute__((address_space(3)))
#define GAS __attribute__((address_space(1)))
typedef unsigned short bf16;
typedef short bf16x8 __attribute__((ext_vector_type(8)));
typedef float f32x4 __attribute__((ext_vector_type(4)));
typedef float f32x2 __attribute__((ext_vector_type(2)));
typedef unsigned u32x4 __attribute__((ext_vector_type(4)));
typedef unsigned u32x2 __attribute__((ext_vector_type(2)));
typedef int v4i __attribute__((ext_vector_type(4)));
typedef int v8i __attribute__((ext_vector_type(8)));

constexpr int NB_ = 8, SEQ = 4096, DM = 1024, NTOK = NB_ * SEQ;
constexpr int CONVW = 384, FOURW = 256, SGUW_ = 384, NMAIN = 1536, NFOUR = 512, WIN_COLS = 1792;
constexpr int NEXP = 64, DFF = 512, NMOD = 6 * DM;
constexpr float EPS = 1e-6f;
constexpr int NWAVES = 8, NTHREADS = 512;

constexpr size_t MiB = 1u << 20;
constexpr size_t WS_CTL = 0, CTL_ZERO_BYTES = 1 * MiB;
constexpr size_t WS_MOD = 1 * MiB;
constexpr size_t WS_ROUTERT = 1 * MiB + 512 * 1024;
constexpr size_t WS_SGUW = 2 * MiB;
constexpr size_t WS_WINT = 3 * MiB;
constexpr size_t WS_WINF = 9 * MiB;
constexpr size_t WS_WOUTT = 11 * MiB;
constexpr size_t WS_GW = 15 * MiB;
constexpr size_t WS_GWL = 62 * MiB;
constexpr size_t WS_LIST = 16 * MiB;
constexpr size_t WS_TG = 24 * MiB;
constexpr size_t WS_FT1 = 60 * MiB;
constexpr size_t WS_FT2 = 61 * MiB;
constexpr size_t WS_W13T = 88 * MiB;
constexpr size_t WS_H8 = 216 * MiB;
constexpr size_t WS_W2T = 344 * MiB;
constexpr size_t WS_XA = 472 * MiB;
constexpr size_t WS_HB = 600 * MiB;
constexpr size_t WS_ZMAIN = 664 * MiB;
constexpr size_t WS_ZT = 760 * MiB;
constexpr size_t WS_MIX = 792 * MiB;
constexpr size_t WS_CONTRIB = 856 * MiB;
constexpr size_t WS_END = 984 * MiB;
constexpr int CW_TMO = 0, CW_CODE = 1;
constexpr int CW_BAR = 4096;
constexpr int CW_CNT = 16384;
constexpr int CW_CHK = 32768;

constexpr int RING_BYTES = 131072;
constexpr int MISC_OFF = RING_BYTES;
constexpr int LDS_BYTES = 147456;
constexpr int M_BAR = 0, M_CNT = 256, M_PRE = 512, M_DESC = 1024, M_NU = 1152;

#define RLX_AGENT __ATOMIC_RELAXED, __HIP_MEMORY_SCOPE_AGENT
#define LDS_WAIT() asm volatile("s_waitcnt lgkmcnt(0)" ::: "memory")
#define VM_WAIT() asm volatile("s_waitcnt vmcnt(0)" ::: "memory")

__device__ __forceinline__ unsigned f2bf(float f) { unsigned u = __builtin_bit_cast(unsigned, f); return (u + 0x7fffu + ((u >> 16) & 1u)) >> 16; }
__device__ __forceinline__ unsigned pk2(float lo, float hi) { return f2bf(lo) | (f2bf(hi) << 16); }
__device__ __forceinline__ float bf2f(unsigned short b) { return __builtin_bit_cast(float, ((unsigned)b) << 16); }
__device__ __forceinline__ float bflo(unsigned w) { return __builtin_bit_cast(float, w << 16); }
__device__ __forceinline__ float bfhi(unsigned w) { return __builtin_bit_cast(float, w & 0xffff0000u); }
__device__ __forceinline__ unsigned pk4_fp8(float a, float b, float c, float d) {
    int w = __builtin_amdgcn_cvt_pk_fp8_f32(a, b, 0, false); w = __builtin_amdgcn_cvt_pk_fp8_f32(c, d, w, true); return (unsigned)w; }
__device__ __forceinline__ float clamp448(float x) { return fminf(fmaxf(x, -448.0f), 448.0f); }
constexpr float W8_SCALE = 64.0f, H8_SCALE = 4.0f;
__device__ __forceinline__ float sigmoidf_(float x) { return __builtin_amdgcn_rcpf(1.0f + __expf(-x)); }
__device__ __forceinline__ float gelu_tanh(float x) { const float y = 0.7978845608028654f * (x + 0.044715f * x * x * x); return x * sigmoidf_(2.0f * y); }
__device__ __forceinline__ int opaque_tid() { int t = threadIdx.x; asm volatile("" : "+v"(t)); return t; }
#define PHASE_LOCALS(F) const int tid = opaque_tid(), lane = tid & 63, wave = __builtin_amdgcn_readfirstlane(tid >> 6); unsigned char* ws = (F).ws; asm volatile("" : "+s"(ws)); (void)tid; (void)lane; (void)wave; (void)ws
template <int CTRL> __device__ __forceinline__ float dpp_f(float v) { return __builtin_bit_cast(float, __builtin_amdgcn_update_dpp(0, __builtin_bit_cast(int, v), CTRL, 0xf, 0xf, false)); }
__device__ __forceinline__ float wave_sum(float v) {
    v += dpp_f<0xB1>(v);
    v += dpp_f<0x4E>(v);
    v += dpp_f<0x141>(v);
    v += dpp_f<0x140>(v);
    const int iv = __builtin_bit_cast(int, v);
    const float r0 = __builtin_bit_cast(float, __builtin_amdgcn_readlane(iv, 0)), r1 = __builtin_bit_cast(float, __builtin_amdgcn_readlane(iv, 16));
    const float r2 = __builtin_bit_cast(float, __builtin_amdgcn_readlane(iv, 32)), r3 = __builtin_bit_cast(float, __builtin_amdgcn_readlane(iv, 48));
    return (r0 + r1) + (r2 + r3);
}

namespace pg8 {
constexpr int BM = 256, BK = 64, HALF = 128, HTB = HALF * BK * 2, STAGE_BYTES = 8 * HTB, NXCD = 8, WGM = 8;
__host__ __device__ __forceinline__ int lds_byte(int r, int c) { const int st = (r >> 4) * 2 + (c >> 5), rr = r & 15, cc = c & 31, ob = rr * 64 + cc * 2; return st * 1024 + (ob ^ (((ob >> 9) & 1) << 5)); }
__host__ __device__ __forceinline__ void stage_rc(int b, int& R, int& C) { const int st = b / 1024, sb = b % 1024, swz = sb ^ (((sb >> 9) & 1) << 5); R = (st >> 1) * 16 + swz / 64; C = (st & 1) * 32 + (swz % 64) / 2; }
__host__ __device__ __forceinline__ int perm32(int rho) { const int n = rho >> 4, i = rho & 15; return 8 * (i >> 2) + 4 * n + (i & 3); }

struct GUnit { const char* a; const char* b; const int* alist; int arow0, nvalid, kind, pm, pn, aux; };

struct StaticMap {
    int nM, nN, nwg;
    __device__ __forceinline__ void init(int M, int N) { nM = M / BM; nN = N / BM; nwg = nM * nN; }
    __device__ __forceinline__ void map(int L, int& pm, int& pn) const {
        int wgid = L; { const int q = nwg / NXCD, r = nwg % NXCD, xcd = wgid % NXCD, off = wgid / NXCD; wgid = (xcd < r ? xcd * (q + 1) : r * (q + 1) + (xcd - r) * q) + off; }
        const int nig = WGM * nN, gid = wgid / nig, fm = gid * WGM, gsz = (nM - fm) < WGM ? (nM - fm) : WGM;
        pm = fm + ((wgid % nig) % gsz); pn = (wgid % nig) / gsz;
    }
};

__device__ __forceinline__ unsigned cvt_pk_bf16(float lo, float hi) { unsigned r; asm volatile("v_cvt_pk_bf16_f32 %0, %1, %2" : "=v"(r) : "v"(lo), "v"(hi)); return r; }

__device__ __forceinline__ void glds16s(const char* sbase, unsigned voff, unsigned lds_dst) {
    unsigned keep;
    asm volatile("s_mov_b32 %0, m0\n\ts_mov_b32 m0, %3\n\ts_nop 0\n\tglobal_load_lds_dwordx4 %1, %2\n\ts_mov_b32 m0, %0" : "=&s"(keep) : "v"(voff), "s"(sbase), "s"(lds_dst) : "memory");
}
template <class Epi, class Sched, bool ALIGN_EPI, bool FP8 = false>
__device__ __forceinline__ void gemm_phase(LAS unsigned char* lds, const int K, const Sched& S, const Epi& E) {
    const int tid = opaque_tid(), wid = __builtin_amdgcn_readfirstlane(tid >> 6), lane = tid & 63, wr = wid >> 2, wc = wid & 3, fr = lane & 15, fq = lane >> 4;
    const int nt = K / BK;
    unsigned voffB[2];
#pragma unroll
    for (int i = 0; i < 2; ++i) { int R, C; stage_rc(tid * 16 + i * 8192, R, C); const int Rb = Epi::PERM ? ((R & ~31) + perm32(R & 31)) : R; voffB[i] = (unsigned)(Rb * K + C) * 2u; }
    const size_t kstep = (size_t)(BK * 2);
    const size_t hstepB = (size_t)HALF * K * 2;
    const unsigned ldsw = (unsigned)wid * 1024u;
    const unsigned ldsb = (unsigned)(size_t)lds;
    const int aoff = lds_byte(wr * 64 + fr, fq * 8), boff = lds_byte(wc * 32 + fr, fq * 8);
#define PG8_SA(b, h) (((b) * 2 + (h)) * HTB)
#define PG8_SB(b, h) ((4 + (b) * 2 + (h)) * HTB)
#define PG8_STAGE_B(bufoff, gbase) do { _Pragma("unroll") for (int _i = 0; _i < 2; ++_i) \
        glds16s((const char*)(gbase), voffB[_i], ldsb + (unsigned)(bufoff) + ldsw + (unsigned)(_i * 8192)); } while (0)
#define PG8_STAGE_A(bufoff, gbase, kb, vo) do { _Pragma("unroll") for (int _i = 0; _i < 2; ++_i) \
        glds16s((const char*)(gbase) + (size_t)(kb), (vo)[_i], ldsb + (unsigned)(bufoff) + ldsw + (unsigned)(_i * 8192)); } while (0)
#define PG8_LOAD_ROWS(dst, u) do { _Pragma("unroll") for (int _h = 0; _h < 2; ++_h) _Pragma("unroll") for (int _i = 0; _i < 2; ++_i) { int _R, _C; stage_rc(tid * 16 + _i * 8192, _R, _C); \
        dst[_h][_i] = S.arow(u, _h * HALF + _R); } } while (0)
#define PG8_ROWS_TO_VO(dst, src) do { _Pragma("unroll") for (int _h = 0; _h < 2; ++_h) _Pragma("unroll") for (int _i = 0; _i < 2; ++_i) { int _R, _C; stage_rc(tid * 16 + _i * 8192, _R, _C); \
        dst[_h][_i] = (unsigned)(S.fin(src[_h][_i]) * K + _C) * 2u; } } while (0)
#define PG8_LDA(dst, b, h) do { _Pragma("unroll") for (int m = 0; m < 4; ++m) { dst[m].lo = *(const LAS v4i*)(lds + PG8_SA(b, h) + aoff + m * 2048); dst[m].hi = *(const LAS v4i*)(lds + PG8_SA(b, h) + aoff + m * 2048 + 1024); } } while (0)
#define PG8_LDB(dst, b, h) do { _Pragma("unroll") for (int n = 0; n < 2; ++n) { dst[n].lo = *(const LAS v4i*)(lds + PG8_SB(b, h) + boff + n * 2048); dst[n].hi = *(const LAS v4i*)(lds + PG8_SB(b, h) + boff + n * 2048 + 1024); } } while (0)
#define PG8_MMA(ai, bj, At, Bt) do { __builtin_amdgcn_s_setprio(1); \
        if constexpr (FP8 && FP8_MODE == 2) { _Pragma("unroll") for (int m = 0; m < 4; ++m) _Pragma("unroll") for (int n = 0; n < 2; ++n) \
            asm volatile("v_mfma_scale_f32_16x16x128_f8f6f4 %0, %1, %2, %0, %3, %3 op_sel_hi:[0,0,0]" : "+v"(acc[ai][bj][m][n]) : "v"(Bt[n]), "v"(At[m]), "v"(sc1)); } \
        else if constexpr (FP8) { _Pragma("unroll") for (int m = 0; m < 4; ++m) _Pragma("unroll") for (int n = 0; n < 2; ++n) _Pragma("unroll") for (int q = 0; q < 4; ++q) { \
            const long aq = ((long)(unsigned)At[m][2 * q]) | ((long)At[m][2 * q + 1] << 32), bq = ((long)(unsigned)Bt[n][2 * q]) | ((long)Bt[n][2 * q + 1] << 32); \
            acc[ai][bj][m][n] = __builtin_amdgcn_mfma_f32_16x16x32_fp8_fp8(bq, aq, acc[ai][bj][m][n], 0, 0, 0); } } \
        else { _Pragma("unroll") for (int m = 0; m < 4; ++m) _Pragma("unroll") for (int n = 0; n < 2; ++n) { \
            const v4i a_lo = At[m].lo, a_hi = At[m].hi, b_lo = Bt[n].lo, b_hi = Bt[n].hi;     \
            acc[ai][bj][m][n] = __builtin_amdgcn_mfma_f32_16x16x32_bf16(__builtin_bit_cast(bf16x8, b_lo), __builtin_bit_cast(bf16x8, a_lo), acc[ai][bj][m][n], 0, 0, 0); \
            acc[ai][bj][m][n] = __builtin_amdgcn_mfma_f32_16x16x32_bf16(__builtin_bit_cast(bf16x8, b_hi), __builtin_bit_cast(bf16x8, a_hi), acc[ai][bj][m][n], 0, 0, 0); } } \
        __builtin_amdgcn_s_setprio(0); } while (0)
#define PG8_WAIT_V(n) asm volatile("s_waitcnt vmcnt(" #n ")" ::: "memory")
#define PG8_WAIT_L(n) asm volatile("s_waitcnt lgkmcnt(" #n ")" ::: "memory")
#define PG8_BAR __builtin_amdgcn_s_barrier()
#define PG8_SCHED __builtin_amdgcn_sched_barrier(0)
    GUnit cur, nxt; int ui = 0;
    if (!S.next(0, cur)) return;
    f32x4 acc[2][2][4][2];
#pragma unroll
    for (int a = 0; a < 2; ++a)
#pragma unroll
        for (int b = 0; b < 2; ++b)
#pragma unroll
            for (int m = 0; m < 4; ++m)
#pragma unroll
                for (int n = 0; n < 2; ++n) acc[a][b][m][n] = (f32x4){0.f, 0.f, 0.f, 0.f};
    int sc1 = 0x7F7F7F7F; asm volatile("" : "+v"(sc1));
    v8i At[4], B0[2], B1[2];
    unsigned vo[2][2];
    { int r0[2][2]; PG8_LOAD_ROWS(r0, cur); PG8_ROWS_TO_VO(vo, r0); }
    const char* ca = cur.a; const char* cB = cur.b;
    PG8_STAGE_B(PG8_SB(0, 0), cB); PG8_STAGE_B(PG8_SB(0, 1), cB + hstepB); PG8_STAGE_A(PG8_SA(0, 0), ca, 0, vo[0]); PG8_STAGE_A(PG8_SA(0, 1), ca, 0, vo[1]);
    if (wr == 1) PG8_BAR;
    PG8_WAIT_V(2); PG8_BAR;
    PG8_STAGE_B(PG8_SB(1, 0), cB + kstep); PG8_STAGE_A(PG8_SA(1, 0), ca, kstep, vo[0]); PG8_STAGE_B(PG8_SB(1, 1), cB + hstepB + kstep);
    PG8_WAIT_V(6); PG8_BAR;
    for (;;) {
        const bool has_next = S.next(ui + 1, nxt);
        const char* na = has_next ? nxt.a : ca; const char* nB = has_next ? nxt.b : cB;
        for (int t = 0; t < nt; t += 2) {
            const bool last = (t == nt - 2);
            const bool sw = last && has_next;
            const size_t k1 = (size_t)(t + 1) * kstep;
            const char* a2 = last ? na : ca; const size_t k2 = last ? (size_t)0 : (size_t)(t + 2) * kstep;
            const char* b2 = last ? nB : cB + (size_t)(t + 2) * kstep; const char* b3 = b2 + kstep;
            int nr[2][2];
            if (sw) PG8_LOAD_ROWS(nr, nxt);
            PG8_LDB(B0, 0, 0); PG8_LDB(B1, 0, 1); PG8_SCHED; PG8_LDA(At, 0, 0); PG8_STAGE_A(PG8_SA(1, 1), ca, k1, vo[1]);
            PG8_WAIT_V(8); PG8_WAIT_L(0); PG8_BAR; PG8_MMA(0, 0, At, B0); PG8_MMA(0, 1, At, B1); PG8_BAR; PG8_SCHED;
            if (sw) PG8_ROWS_TO_VO(vo, nr);
            PG8_LDA(At, 0, 1); PG8_STAGE_B(PG8_SB(0, 0), b2); PG8_STAGE_B(PG8_SB(0, 1), b2 + hstepB); PG8_STAGE_A(PG8_SA(0, 0), a2, k2, vo[0]);
            PG8_WAIT_V(8); PG8_WAIT_L(0); PG8_BAR; PG8_MMA(1, 0, At, B0); PG8_MMA(1, 1, At, B1); PG8_BAR; PG8_SCHED;
            PG8_LDB(B0, 1, 0); PG8_LDB(B1, 1, 1); PG8_SCHED; PG8_LDA(At, 1, 0); PG8_STAGE_A(PG8_SA(0, 1), a2, k2, vo[1]);
            PG8_WAIT_V(8); PG8_WAIT_L(0); PG8_BAR; PG8_MMA(0, 0, At, B0); PG8_MMA(0, 1, At, B1); PG8_BAR; PG8_SCHED;
            PG8_LDA(At, 1, 1); PG8_STAGE_B(PG8_SB(1, 0), b3); PG8_STAGE_B(PG8_SB(1, 1), b3 + hstepB); PG8_STAGE_A(PG8_SA(1, 0), a2, k2 + kstep, vo[0]);
            PG8_WAIT_V(8); PG8_WAIT_L(0); PG8_BAR; PG8_MMA(1, 0, At, B0); PG8_MMA(1, 1, At, B1); PG8_BAR; PG8_SCHED;
        }
        if constexpr (ALIGN_EPI) { if (wr == 0) PG8_BAR; }
        if constexpr (FP8) asm volatile("s_nop 15\n\ts_nop 15" ::: "memory");
        E(acc, cur, wr, wc, fr, fq);
        if (!has_next) break;
#pragma unroll
        for (int a = 0; a < 2; ++a)
#pragma unroll
            for (int b = 0; b < 2; ++b)
#pragma unroll
                for (int m = 0; m < 4; ++m)
#pragma unroll
                    for (int n = 0; n < 2; ++n) acc[a][b][m][n] = (f32x4){0.f, 0.f, 0.f, 0.f};
        cur = nxt; ca = na; cB = nB; ++ui;
        if constexpr (ALIGN_EPI) { if (wr == 1) PG8_BAR; }
    }
    PG8_WAIT_V(0);
    if constexpr (!ALIGN_EPI) { if (wr == 0) PG8_BAR; }
    PG8_BAR;
#undef PG8_SA
#undef PG8_SB
#undef PG8_STAGE_A
#undef PG8_STAGE_B
#undef PG8_LOAD_ROWS
#undef PG8_ROWS_TO_VO
#undef PG8_LDA
#undef PG8_LDB
#undef PG8_MMA
#undef PG8_WAIT_V
#undef PG8_WAIT_L
#undef PG8_BAR
#undef PG8_SCHED
}
}
using pg8::GUnit;

#define XB_TMO      128
#define XB_XCNT(j)  (256  + 64 * (j))
#define XB_XSUB(j)  (1280 + 64 * (j))
#define XB_XGEN(j)  (2304 + 64 * (j))
#define XB_TOP      3328
#define XB_TOPGEN   3392
#define XCD_BAR_WORDS 3456
#define XB_SPIN_CAP (1u << 18)
__device__ __forceinline__ unsigned xb_ld(unsigned* p)              { return __hip_atomic_load(p, __ATOMIC_RELAXED, __HIP_MEMORY_SCOPE_AGENT); }
__device__ __forceinline__ unsigned xb_add(unsigned* p, unsigned v) { return __hip_atomic_fetch_add(p, v, __ATOMIC_RELAXED, __HIP_MEMORY_SCOPE_AGENT); }
__device__ __forceinline__ unsigned xb_xcc_id() { return (unsigned)__builtin_amdgcn_s_getreg((3 << 11) | 20) & 0xFu; }
#define XB_SPIN(cond, bar) do { unsigned _sp = 0; while (cond) { __builtin_amdgcn_s_sleep(1); \
    if ((++_sp & 255u) == 0u) { if (xb_ld(&(bar)[XB_TMO])) break; if (_sp > XB_SPIN_CAP) { atomicAdd(&(bar)[XB_TMO], 1u); break; } } } } while (0)
struct XcdBarrier { unsigned* bar; unsigned x; volatile LAS unsigned* st; };
__device__ __forceinline__ XcdBarrier xcd_barrier_post(unsigned* bar, volatile LAS unsigned* st) {
    XcdBarrier b; b.bar = bar; b.x = xb_xcc_id(); b.st = st;
    if (threadIdx.x == 0) (void)xb_add(&bar[XB_XCNT(b.x)], 1u);
    return b;
}
__device__ __forceinline__ void xcd_barrier_complete(unsigned* bar, unsigned x, unsigned& nloc, unsigned& nx) {
    const unsigned G = gridDim.x * gridDim.y * gridDim.z;
    unsigned sum, cnt, mine, sp = 0u;
    for (;;) {
        sum = 0u; cnt = 0u; mine = 0u;
#pragma unroll
        for (unsigned j = 0; j < 16; ++j) { const unsigned c = xb_ld(&bar[XB_XCNT(j)]); sum += c; cnt += (c > 0u) ? 1u : 0u; mine = (j == x) ? c : mine; }
        if (sum == G) break;
        __builtin_amdgcn_s_sleep(1);
        if ((++sp & 255u) == 0u) { if (xb_ld(&bar[XB_TMO])) break; if (sp > XB_SPIN_CAP) { atomicAdd(&bar[XB_TMO], 1u); break; } }
    }
    nloc = mine > 0u ? mine : 1u; nx = cnt > 0u ? cnt : 1u;
}
__device__ __forceinline__ void xcd_barrier(const XcdBarrier& b) {
    asm volatile("s_waitcnt vmcnt(0)" ::: "memory");
    __syncthreads();
    if (threadIdx.x == 0) {
        unsigned* bar = b.bar;
        __builtin_amdgcn_s_waitcnt(0);
        unsigned nloc = b.st[0], nx = b.st[1];
        if (nloc == 0u) { xcd_barrier_complete(bar, b.x, nloc, nx); b.st[0] = nloc; b.st[1] = nx; }
        const unsigned old = xb_add(&bar[XB_XSUB(b.x)], 1u);
        const unsigned gen = old / nloc;
        if (old + 1u == (gen + 1u) * nloc) {
            __builtin_amdgcn_fence(__ATOMIC_RELEASE, "agent");
            asm volatile("s_waitcnt vmcnt(0)" ::: "memory");
            const unsigned og = xb_add(&bar[XB_TOP], 1u);
            const unsigned tg = og / nx;
            if (og + 1u == (tg + 1u) * nx) xb_add(&bar[XB_TOPGEN], 1u);
            else XB_SPIN(xb_ld(&bar[XB_TOPGEN]) == tg, bar);
            __builtin_amdgcn_fence(__ATOMIC_ACQUIRE, "agent");
            xb_add(&bar[XB_XGEN(b.x)], 1u);
            asm volatile("s_waitcnt vmcnt(0)" ::: "memory");
        } else {
            XB_SPIN(xb_ld(&bar[XB_XGEN(b.x)]) == gen, bar);
            __builtin_amdgcn_fence(__ATOMIC_ACQUIRE, "agent");
            asm volatile("s_waitcnt vmcnt(0)" ::: "memory");
        }
    }
    __syncthreads();
}

struct Args {
    const float* in[22];
    float* out; unsigned char* ws;
    int ph_lo, ph_hi;
};
struct Frame {
    LAS unsigned char* lds;
    unsigned* ctl;
    int vcu, G, bx;
    unsigned char* ws;
    const Args* A;
    float* out;
};

struct SchedWin {
    static constexpr bool GATHER = false;
    pg8::StaticMap sm; int G, c; const char* hb; const char* wmain; const char* wf;
    __device__ __forceinline__ bool next(int i, GUnit& u) const {
        int L = i * G + c; u.alist = nullptr; u.nvalid = 256;
        if (L < 768) { int pm, pn; sm.map(L, pm, pn); u.a = hb; u.arow0 = pm * 256; u.b = wmain + (size_t)pn * 256 * DM * 2; u.kind = 0; u.pm = pm; u.pn = pn; u.aux = 0; return true; }
        L -= 768; if (L >= 256) return false;
        const int b_ = L & 7, r32 = L >> 3, pm = r32 >> 1, pn = r32 & 1;
        u.a = hb; u.arow0 = pm * 256; u.b = wf + (size_t)pn * 256 * DM * 2; u.kind = 1; u.pm = pm; u.pn = pn; u.aux = b_; return true;
    }
    __device__ __forceinline__ int arow(const GUnit& u, int r) const { const int n = u.arow0 + r; return u.kind == 0 ? n : u.aux * SEQ + ((n & 63) << 6) + (n >> 6); }
    __device__ __forceinline__ int fin(int x) const { return x; }
};
struct EpiWin {
    static constexpr bool PERM = true;
    bf16* zmain; bf16* zt;
    __device__ __forceinline__ void operator()(const f32x4 (&acc)[2][2][4][2], const GUnit& u, int wr, int wc, int fr, int fq) const {
        if (u.kind == 0) {
#pragma unroll
            for (int ai = 0; ai < 2; ++ai)
#pragma unroll
                for (int m = 0; m < 4; ++m) {
                    const int rr = ai * 128 + wr * 64 + m * 16 + fr;
                    bf16* rowp = zmain + (size_t)(u.pm * 256 + rr) * NMAIN + u.pn * 256 + wc * 32 + 8 * fq;
#pragma unroll
                    for (int bj = 0; bj < 2; ++bj) { const f32x4 v0 = acc[ai][bj][m][0], v1 = acc[ai][bj][m][1];
                        u32x4 w; w.x = pg8::cvt_pk_bf16(v0[0], v0[1]); w.y = pg8::cvt_pk_bf16(v0[2], v0[3]); w.z = pg8::cvt_pk_bf16(v1[0], v1[1]); w.w = pg8::cvt_pk_bf16(v1[2], v1[3]);
                        *(u32x4*)(rowp + bj * 128) = w; }
                }
        } else {
#pragma unroll
            for (int ai = 0; ai < 2; ++ai)
#pragma unroll
                for (int m = 0; m < 4; ++m) {
                    const int s1 = m * 16 + fr, s2 = u.pm * 4 + ai * 2 + wr;
                    bf16* base = zt + ((size_t)(u.aux * 256 + wc * 32 + 8 * fq) * 64 + s2) * 128 + u.pn * 64 + s1;
                    asm volatile("" : "+v"(base));
#pragma unroll
                    for (int bj = 0; bj < 2; ++bj)
#pragma unroll
                        for (int n = 0; n < 2; ++n)
#pragma unroll
                            for (int j = 0; j < 4; ++j) { const int col = bj * 128 + 4 * n + j; base[(size_t)col * 64 * 128] = (bf16)f2bf(acc[ai][bj][m][n][j]); }
                    asm volatile("" ::: "memory");
                }
        }
    }
};
struct SchedWout {
    static constexpr bool GATHER = false;
    pg8::StaticMap sm; int G, c; const char* mix; const char* wt;
    __device__ __forceinline__ bool next(int i, GUnit& u) const {
        const int L = i * G + c; if (L >= sm.nwg) return false;
        int pm, pn; sm.map(L, pm, pn); u.a = mix; u.arow0 = pm * 256; u.b = wt + (size_t)pn * 256 * DM * 2; u.kind = 0; u.pm = pm; u.pn = pn; u.aux = 0; u.alist = nullptr; u.nvalid = 256; return true;
    }
    __device__ __forceinline__ int arow(const GUnit& u, int r) const { return u.arow0 + r; }
    __device__ __forceinline__ int fin(int x) const { return x; }
};
struct EpiWout {
    static constexpr bool PERM = true;
    const float* x32; bf16* xa; const float* gate;
    __device__ __forceinline__ void operator()(const f32x4 (&acc)[2][2][4][2], const GUnit& u, int wr, int wc, int fr, int fq) const {
        const int b_ = u.pm >> 4; const int col0 = u.pn * 256 + wc * 32 + 8 * fq;
        f32x4 gv[2][2];
#pragma unroll
        for (int bj = 0; bj < 2; ++bj)
#pragma unroll
            for (int n = 0; n < 2; ++n) gv[bj][n] = *(const f32x4*)(gate + (size_t)b_ * NMOD + col0 + bj * 128 + n * 4);
#pragma unroll
        for (int ai = 0; ai < 2; ++ai)
#pragma unroll
            for (int m = 0; m < 4; ++m) { const size_t off = (size_t)(u.pm * 256 + ai * 128 + wr * 64 + m * 16 + fr) * DM + col0;
#pragma unroll
                for (int bj = 0; bj < 2; ++bj) {
                    f32x4 x0, x1;
                    if (x32) { x0 = *(const f32x4*)(x32 + off + bj * 128); x1 = *(const f32x4*)(x32 + off + bj * 128 + 4); }
                    else { const u32x4 xv = *(const u32x4*)(xa + off + bj * 128); x0 = (f32x4){bflo(xv.x), bfhi(xv.x), bflo(xv.y), bfhi(xv.y)}; x1 = (f32x4){bflo(xv.z), bfhi(xv.z), bflo(xv.w), bfhi(xv.w)}; }
                    const f32x4 v0 = x0 + gv[bj][0] * acc[ai][bj][m][0], v1 = x1 + gv[bj][1] * acc[ai][bj][m][1];
                    u32x4 w; w.x = pg8::cvt_pk_bf16(v0[0], v0[1]); w.y = pg8::cvt_pk_bf16(v0[2], v0[3]); w.z = pg8::cvt_pk_bf16(v1[0], v1[1]); w.w = pg8::cvt_pk_bf16(v1[2], v1[3]);
                    *(u32x4*)(xa + off + bj * 128) = w; }
                asm volatile("" ::: "memory"); }
    }
};
struct SchedMoe {
    static constexpr bool GATHER = true;
    const volatile LAS unsigned* desc; const volatile LAS int* cnt; int nu; int which;
    const char* hb; const char* hmoe; const char* wt; const int* list;
    __device__ __forceinline__ bool next(int i, GUnit& u) const {
        if (i >= nu) return false;
        const unsigned d = (unsigned)__builtin_amdgcn_readfirstlane((int)desc[i]);
        const int e = d & 63, pn = (d >> 6) & 3, rb = (d >> 8) & 255, blk = d >> 16;
        const int ce = __builtin_amdgcn_readfirstlane(cnt[e]);
        int nv = ce - rb * 256; nv = nv > 256 ? 256 : nv;
        u.alist = list + (size_t)e * NTOK + rb * 256; u.nvalid = nv; u.kind = e; u.pm = blk; u.pn = pn; u.aux = rb; u.arow0 = blk * 256;
        if (which == 1) { u.a = hb; u.b = wt + ((size_t)e * 1024 + (size_t)pn * 256) * DM; }
        else { u.a = hmoe; u.b = wt + ((size_t)e * 1024 + (size_t)pn * 256) * DFF; }
        return true;
    }
    __device__ __forceinline__ int arow(const GUnit& u, int r) const {
        if (which == 1) return (r < u.nvalid) ? u.alist[r] : 0;
        return u.arow0 + r;
    }
    __device__ __forceinline__ int fin(int x) const { return which == 1 ? (x >> 1) : x; }
};
struct EpiMoe1 {
    static constexpr bool PERM = true;
    unsigned char* hmoe;
    __device__ __forceinline__ void operator()(const f32x4 (&acc)[2][2][4][2], const GUnit& u, int wr, int wc, int fr, int fq) const {
#pragma unroll
        for (int ai = 0; ai < 2; ++ai)
#pragma unroll
            for (int m = 0; m < 4; ++m) {
                const int rr = ai * 128 + wr * 64 + m * 16 + fr;
                unsigned char* rowp = hmoe + (size_t)(u.pm * 256 + rr) * DFF + u.pn * 128 + wc * 32 + 8 * fq;
                float hv[8];
#pragma unroll
                for (int n = 0; n < 2; ++n)
#pragma unroll
                    for (int j = 0; j < 4; ++j) { const float g = acc[ai][0][m][n][j] * (1.0f / W8_SCALE), uu = acc[ai][1][m][n][j] * (H8_SCALE / W8_SCALE); hv[n * 4 + j] = clamp448(g * sigmoidf_(g) * uu); }
                *(u32x2*)rowp = (u32x2){pk4_fp8(hv[0], hv[1], hv[2], hv[3]), pk4_fp8(hv[4], hv[5], hv[6], hv[7])};
            }
    }
};
struct EpiMoe2 {
    static constexpr bool PERM = true;
    bf16* contrib; const int* listbase; const float* gwl;
    __device__ __forceinline__ void operator()(const f32x4 (&acc)[2][2][4][2], const GUnit& u, int wr, int wc, int fr, int fq) const {
        const float* gwp = gwl + (u.alist - listbase);
#pragma unroll
        for (int ai = 0; ai < 2; ++ai)
#pragma unroll
            for (int m = 0; m < 4; ++m) {
                const int rr = ai * 128 + wr * 64 + m * 16 + fr;
                if (rr < u.nvalid) {
                    const int a = u.alist[rr]; const float g = gwp[rr] * (1.0f / (W8_SCALE * H8_SCALE));
                    bf16* rowp = contrib + (size_t)a * DM + u.pn * 256 + wc * 32 + 8 * fq;
#pragma unroll
                    for (int bj = 0; bj < 2; ++bj) { const f32x4 v0 = acc[ai][bj][m][0] * g, v1 = acc[ai][bj][m][1] * g;
                        u32x4 w; w.x = pg8::cvt_pk_bf16(v0[0], v0[1]); w.y = pg8::cvt_pk_bf16(v0[2], v0[3]); w.z = pg8::cvt_pk_bf16(v1[0], v1[1]); w.w = pg8::cvt_pk_bf16(v1[2], v1[3]);
                        *(u32x4*)(rowp + bj * 128) = w; }
                }
            }
    }
};

__device__ __forceinline__ void transpose_item(const float* W, int ldw, int col0, int k0, bf16* dst, int kdst, LAS float* scr, int lane) {
    float tv[32];
#pragma unroll
    for (int i = 0; i < 32; ++i) { const int kk = 2 * i + (lane >> 5); tv[i] = __builtin_nontemporal_load(W + (size_t)(k0 + kk) * ldw + col0 + (lane & 31)); }
#pragma unroll
    for (int i = 0; i < 32; ++i) { const int kk = 2 * i + (lane >> 5); scr[kk * 33 + (lane & 31)] = tv[i]; }
    LDS_WAIT(); asm volatile("" ::: "memory");
    const int c = lane & 7;
#pragma unroll
    for (int j = 0; j < 4; ++j) { const int n = (lane >> 3) + 8 * j; const LAS float* s = scr + (8 * c) * 33 + n;
        u32x4 o; o.x = pk2(s[0 * 33], s[1 * 33]); o.y = pk2(s[2 * 33], s[3 * 33]); o.z = pk2(s[4 * 33], s[5 * 33]); o.w = pk2(s[6 * 33], s[7 * 33]);
        *(u32x4*)(dst + (size_t)n * kdst + k0 + 8 * c) = o; }
    LDS_WAIT(); asm volatile("" ::: "memory");
}

__device__ __forceinline__ void transpose_item_f8(const float* W, int ldw, int col0, int k0, unsigned char* dst, int kdst, LAS float* scr, int lane) {
    float tv[32];
#pragma unroll
    for (int i = 0; i < 32; ++i) { const int kk = 2 * i + (lane >> 5); tv[i] = __builtin_nontemporal_load(W + (size_t)(k0 + kk) * ldw + col0 + (lane & 31)); }
#pragma unroll
    for (int i = 0; i < 32; ++i) { const int kk = 2 * i + (lane >> 5); scr[kk * 33 + (lane & 31)] = tv[i] * W8_SCALE; }
    LDS_WAIT(); asm volatile("" ::: "memory");
    const int c = lane & 7;
#pragma unroll
    for (int j = 0; j < 4; ++j) { const int n = (lane >> 3) + 8 * j; const LAS float* sp = scr + (8 * c) * 33 + n;
        *(u32x2*)(dst + (size_t)n * kdst + k0 + 8 * c) = (u32x2){pk4_fp8(sp[0 * 33], sp[1 * 33], sp[2 * 33], sp[3 * 33]), pk4_fp8(sp[4 * 33], sp[5 * 33], sp[6 * 33], sp[7 * 33])}; }
    LDS_WAIT(); asm volatile("" ::: "memory");
}

__device__ __forceinline__ void p0_prologue(Frame& F) {
    PHASE_LOCALS(F);
    float* MOD = (float*)(ws + WS_MOD);
    if (F.bx < 192) {
        LAS float* sc = (LAS float*)F.lds;
        LAS float* red = (LAS float*)(F.lds + 32768);
        const int l = F.bx / 96, cb = F.bx % 96;
        for (int i = tid; i < NB_ * DM; i += NTHREADS) { const float v = F.A->in[1][i]; sc[i] = v * sigmoidf_(v); }
        __syncthreads();
        const int col = cb * 64 + lane, ks = wave;
        float acc[8];
#pragma unroll
        for (int b = 0; b < 8; ++b) acc[b] = 0.f;
        const float* wp = F.A->in[4] + ((size_t)l * DM + (size_t)ks * 128) * NMOD + col;
#pragma unroll 8
        for (int kk = 0; kk < 128; ++kk) { const float w = wp[(size_t)kk * NMOD];
#pragma unroll
            for (int b = 0; b < 8; ++b) acc[b] += sc[b * DM + ks * 128 + kk] * w; }
#pragma unroll
        for (int b = 0; b < 8; ++b) red[(ks * 8 + b) * 64 + lane] = acc[b];
        __syncthreads();
        { const int b = wave; float s = F.A->in[5][(size_t)l * NMOD + col];
#pragma unroll
          for (int k2 = 0; k2 < 8; ++k2) s += red[(k2 * 8 + b) * 64 + lane];
          MOD[((size_t)l * 8 + b) * NMOD + col] = s; }
        __syncthreads();
    }
    const int gw = F.vcu * NWAVES + wave, NGW = F.G * NWAVES;
    const int gt = F.bx * NTHREADS + tid, NGT = F.G * NTHREADS;
    {
        bf16* ft1 = (bf16*)(ws + WS_FT1); bf16* ft2 = (bf16*)(ws + WS_FT2);
        for (int i = gt; i < 128 * 128 + 64 * 128; i += NGT) {
            if (i < 128 * 128) { const int n = i >> 7, kk = i & 127, k1 = n >> 1, pp = n & 1, p = kk >> 6, s1 = kk & 63;
                const float x = (float)((s1 * k1) & 63) * (1.0f / 32.0f); const float cs = cospif(x), sn = sinpif(x);
                const float v = pp == 0 ? (p == 0 ? cs : -sn) : (p == 0 ? sn : cs); ft1[i] = (bf16)f2bf(v); }
            else { const int q = i - 128 * 128, k2 = q >> 7, kk = q & 127, p = kk >> 6, s2 = kk & 63;
                const float x = (float)((s2 * k2) & 63) * (1.0f / 32.0f); const float v = (p == 0 ? cospif(x) : -sinpif(x)) * (1.0f / 512.0f); ft2[q] = (bf16)f2bf(v); }
        }
    }
    { bf16* sw = (bf16*)(ws + WS_SGUW);
      for (int i = gt; i < 2 * 6 * 128 * 128 / 2; i += NGT) { const f32x2 v = *(const f32x2*)(F.A->in[14] + 2 * (size_t)i); *(unsigned*)(sw + 2 * (size_t)i) = pk2(v.x, v.y); } }
    {
        LAS float* t64 = (LAS float*)(F.lds + 16384);
        if (tid < 64) t64[tid] = cospif((float)tid * (1.0f / 32.0f));
        __syncthreads();
        bf16* wf = (bf16*)(ws + WS_WINF);
        for (int it = gw; it < 2 * 4 * 16 * 2 * 4; it += NGW) {
            const int jq = it & 3, part = (it >> 2) & 1, kb = (it >> 3) & 15, g = (it >> 7) & 3, l = it >> 9;
            const int k = kb * 64 + lane;
            const float* src = F.A->in[6] + ((size_t)l * DM + k) * WIN_COLS + 768 + g * 64;
            float wv[64];
#pragma unroll
            for (int c4 = 0; c4 < 16; ++c4) { const f32x4 v = *(const f32x4*)(src + 4 * c4); wv[4 * c4] = v.x; wv[4 * c4 + 1] = v.y; wv[4 * c4 + 2] = v.z; wv[4 * c4 + 3] = v.w; }
            for (int jj = 0; jj < 16; ++jj) { const int j = jq * 16 + jj; float s = 0.f;
#pragma unroll
                for (int c = 0; c < 64; ++c) { const int t = (c * j + (part ? 48 : 0)) & 63; s += wv[c] * t64[t]; }
                wf[((size_t)l * NFOUR + part * 256 + g * 64 + j) * DM + k] = (bf16)f2bf(s); }
        }
        __syncthreads();
    }
    {
        LAS float* scr = (LAS float*)(F.lds + wave * 16384);
        constexpr int I_EXP = 2 * 64 * 3 * 256, I_WIN = 2 * 768, I_WOUT = 2 * 512, I_R = 32;
        for (int it = gw; it < I_EXP + I_WIN + I_WOUT + I_R; it += NGW) {
            int r = it;
            if (r < I_EXP) {
                const int sub = r & 255, mat = r >> 8, which = mat % 3, le = mat / 3;
                if (which < 2) { const int nb = sub & 15, kb = sub >> 4, n0 = nb * 32; const float* W = (which == 0 ? F.A->in[18] : F.A->in[19]) + (size_t)le * DM * DFF;
                    unsigned char* dst = (ws + WS_W13T) + ((size_t)le * 1024 + (n0 >> 7) * 256 + which * 128 + (n0 & 127)) * DM;
                    transpose_item_f8(W, DFF, n0, kb * 64, dst, DM, scr, lane); }
                else { const int nb = sub & 31, kb = sub >> 5, n0 = nb * 32; const float* W = F.A->in[20] + (size_t)le * DFF * DM;
                    unsigned char* dst = (ws + WS_W2T) + ((size_t)le * 1024 + n0) * DFF;
                    transpose_item_f8(W, DM, n0, kb * 64, dst, DFF, scr, lane); }
                continue; }
            r -= I_EXP;
            if (r < I_WIN) { const int l = r / 768, sub = r % 768, nb = sub % 48, kb = sub / 48, n0 = nb * 32; const int col0 = n0 < 768 ? n0 : n0 + 256;
                transpose_item(F.A->in[6] + (size_t)l * DM * WIN_COLS, WIN_COLS, col0, kb * 64, (bf16*)(ws + WS_WINT) + ((size_t)l * NMAIN + n0) * DM, DM, scr, lane); continue; }
            r -= I_WIN;
            if (r < I_WOUT) { const int l = r / 512, sub = r % 512, nb = sub & 31, kb = sub >> 5, n0 = nb * 32;
                transpose_item(F.A->in[7] + (size_t)l * DM * DM, DM, n0, kb * 64, (bf16*)(ws + WS_WOUTT) + ((size_t)l * DM + n0) * DM, DM, scr, lane); continue; }
            r -= I_WOUT;
            { const int nb = r & 1, kb = r >> 1, n0 = nb * 32;
              transpose_item(F.A->in[16], NEXP, n0, kb * 64, (bf16*)(ws + WS_ROUTERT) + (size_t)n0 * DM, DM, scr, lane); }
        }
    }
}

__device__ __forceinline__ void norm_phase(Frame& F, int mode, int l) {
    PHASE_LOCALS(F);
    const int gw = F.vcu * NWAVES + wave, NGW = F.G * NWAVES;
    const float* MOD = (const float*)(ws + WS_MOD);
    bf16* XA = (bf16*)(ws + WS_XA); bf16* HB = (bf16*)(ws + WS_HB); const bf16* CT = (const bf16*)(ws + WS_CONTRIB);
    for (int chunk = gw; chunk < NTOK / 16; chunk += NGW) {
        const int row0 = chunk * 16, b = row0 >> 12;
        f32x4 pa[4], pb[4], g2[4];
#pragma unroll
        for (int j = 0; j < 4; ++j) {
            if (mode == 2) { pa[j] = *(const f32x4*)(F.A->in[21] + 4 * lane + 256 * j); pb[j] = (f32x4){0.f, 0.f, 0.f, 0.f}; }
            else { const float* mp = MOD + ((size_t)l * 8 + b) * NMOD + 4 * lane + 256 * j; pa[j] = *(const f32x4*)(F.A->in[2] + (size_t)l * DM + 4 * lane + 256 * j) * (*(const f32x4*)(mp + DM) + 1.0f); pb[j] = *(const f32x4*)mp; }
            g2[j] = mode != 0 ? *(const f32x4*)(MOD + ((size_t)(l - 1) * 8 + b) * NMOD + 5 * DM + 4 * lane + 256 * j) : (f32x4){0.f, 0.f, 0.f, 0.f};
        }
        for (int i0 = 0; i0 < 16; i0 += 2) {
            f32x4 v[2][4];
            if (mode == 0) {
#pragma unroll
                for (int i = 0; i < 2; ++i)
#pragma unroll
                    for (int j = 0; j < 4; ++j) v[i][j] = *(const f32x4*)(F.A->in[0] + (size_t)(row0 + i0 + i) * DM + 4 * lane + 256 * j);
            } else {
                u32x2 xx[2][4], ca[2][4], cb[2][4];
#pragma unroll
                for (int i = 0; i < 2; ++i)
#pragma unroll
                    for (int j = 0; j < 4; ++j) { const size_t r = (size_t)(row0 + i0 + i); xx[i][j] = *(const u32x2*)(XA + r * DM + 4 * lane + 256 * j);
                        ca[i][j] = *(const u32x2*)(CT + (2 * r) * DM + 4 * lane + 256 * j); cb[i][j] = *(const u32x2*)(CT + (2 * r + 1) * DM + 4 * lane + 256 * j); }
#pragma unroll
                for (int i = 0; i < 2; ++i)
#pragma unroll
                    for (int j = 0; j < 4; ++j) { const f32x4 g = g2[j]; const u32x2 x = xx[i][j], a = ca[i][j], c = cb[i][j];
                        v[i][j].x = bflo(x.x) + g.x * (bflo(a.x) + bflo(c.x)); v[i][j].y = bfhi(x.x) + g.y * (bfhi(a.x) + bfhi(c.x)); v[i][j].z = bflo(x.y) + g.z * (bflo(a.y) + bflo(c.y)); v[i][j].w = bfhi(x.y) + g.w * (bfhi(a.y) + bfhi(c.y)); }
            }
#pragma unroll
            for (int i = 0; i < 2; ++i) {
                const size_t row = (size_t)(row0 + i0 + i);
                if (mode == 1) {
#pragma unroll
                    for (int j = 0; j < 4; ++j) *(u32x2*)(XA + row * DM + 4 * lane + 256 * j) = (u32x2){pk2(v[i][j].x, v[i][j].y), pk2(v[i][j].z, v[i][j].w)}; }
                float ss = 0.f;
#pragma unroll
                for (int j = 0; j < 4; ++j) ss += (v[i][j].x * v[i][j].x + v[i][j].y * v[i][j].y) + (v[i][j].z * v[i][j].z + v[i][j].w * v[i][j].w);
                const float rs = rsqrtf(wave_sum(ss) * (1.0f / DM) + EPS);
                if (mode == 2) {
#pragma unroll
                    for (int j = 0; j < 4; ++j) *(f32x4*)(F.out + row * DM + 4 * lane + 256 * j) = v[i][j] * rs * pa[j];
                } else {
#pragma unroll
                    for (int j = 0; j < 4; ++j) { const f32x4 h = v[i][j] * rs * pa[j] + pb[j]; *(u32x2*)(HB + row * DM + 4 * lane + 256 * j) = (u32x2){pk2(h.x, h.y), pk2(h.z, h.w)}; }
                }
            }
        }
    }
}

__device__ __forceinline__ void conv_unit(Frame& F, int l, int unit) {
    PHASE_LOCALS(F);
    const int st = unit & 31, hd = (unit >> 5) % 6, b = unit / 192, s0 = st * 128;
    const bf16* ZM = (const bf16*)(ws + WS_ZMAIN); bf16* MIX = (bf16*)(ws + WS_MIX);
    LAS float* T = (LAS float*)F.lds;
    for (int idx = tid; idx < 158 * 8; idx += NTHREADS) {
        const int row = idx >> 3, c8 = idx & 7, s = s0 - 15 + row;
        float o[8];
        if (s >= 0 && s < SEQ) {
            const bf16* p = ZM + (size_t)(b * SEQ + s) * NMAIN + hd * 64 + c8 * 8;
            const u32x4 av = *(const u32x4*)p, gv = *(const u32x4*)(p + CONVW);
            const unsigned aw[4] = {av.x, av.y, av.z, av.w}, gq[4] = {gv.x, gv.y, gv.z, gv.w};
#pragma unroll
            for (int j = 0; j < 4; ++j) { o[2 * j] = bflo(aw[j]) * sigmoidf_(bflo(gq[j])); o[2 * j + 1] = bfhi(aw[j]) * sigmoidf_(bfhi(gq[j])); }
        } else {
#pragma unroll
            for (int j = 0; j < 8; ++j) o[j] = 0.f;
        }
#pragma unroll
        for (int j = 0; j < 8; ++j) T[row * 65 + c8 * 8 + j] = o[j];
    }
    __syncthreads();
    {
        const int c = lane, p0 = wave * 16, ch = hd * 64 + c;
        float w[31];
#pragma unroll
        for (int t = 0; t < 31; ++t) w[t] = F.A->in[8][((size_t)l * 31 + t) * CONVW + ch];
        const float bias = F.A->in[9][l * CONVW + ch], gg = F.A->in[10][l * CONVW + ch], gb = F.A->in[11][l * CONVW + ch];
        float in[46];
#pragma unroll
        for (int j = 0; j < 46; ++j) in[j] = T[(p0 + j) * 65 + c];
#pragma unroll
        for (int i = 0; i < 16; ++i) {
            float a = bias;
#pragma unroll
            for (int t = 0; t < 31; ++t) a += w[t] * in[i + t];
            const float mean = wave_sum(a) * (1.0f / 64.0f), d = a - mean;
            const float var = wave_sum(d * d) * (1.0f / 64.0f);
            float y = d * rsqrtf(var + EPS) * gg + gb; y = y * sigmoidf_(y);
            MIX[(size_t)(b * SEQ + s0 + p0 + i) * DM + ch] = (bf16)f2bf(y);
        }
    }
    __syncthreads();
}

__device__ __forceinline__ void sgu_unit(Frame& F, int l, int unit) {
    PHASE_LOCALS(F);
    const int b = unit >> 5, s0 = (unit & 31) * 128;
    const bf16* ZM = (const bf16*)(ws + WS_ZMAIN); bf16* MIX = (bf16*)(ws + WS_MIX); const bf16* SW = (const bf16*)(ws + WS_SGUW);
    LAS bf16* vT = (LAS bf16*)F.lds;
    constexpr int VP = 136;
    for (int grp = 0; grp < 2; ++grp) {
        const int q0 = wave * 16 + grp * 8;
        float val[8][6];
#pragma unroll
        for (int i = 0; i < 8; ++i) {
            const bf16* p = ZM + (size_t)(b * SEQ + s0 + q0 + i) * NMAIN + 1152 + 2 * lane;
#pragma unroll
            for (int j = 0; j < 3; ++j) { const unsigned wv = *(const unsigned*)(p + 128 * j); val[i][2 * j] = gelu_tanh(bflo(wv)); val[i][2 * j + 1] = gelu_tanh(bfhi(wv)); }
        }
        float lg[6], lb[6];
#pragma unroll
        for (int j = 0; j < 3; ++j) { const f32x2 g = *(const f32x2*)(F.A->in[12] + l * SGUW_ + 2 * lane + 128 * j), bb = *(const f32x2*)(F.A->in[13] + l * SGUW_ + 2 * lane + 128 * j); lg[2 * j] = g.x; lg[2 * j + 1] = g.y; lb[2 * j] = bb.x; lb[2 * j + 1] = bb.y; }
#pragma unroll
        for (int i = 0; i < 8; ++i) {
            float s = 0.f;
#pragma unroll
            for (int j = 0; j < 6; ++j) s += val[i][j];
            const float mean = wave_sum(s) * (1.0f / 384.0f); float q = 0.f;
#pragma unroll
            for (int j = 0; j < 6; ++j) { val[i][j] -= mean; q += val[i][j] * val[i][j]; }
            const float rstd = rsqrtf(wave_sum(q) * (1.0f / 384.0f) + EPS);
#pragma unroll
            for (int j = 0; j < 6; ++j) val[i][j] = val[i][j] * rstd * lg[j] + lb[j];
        }
#pragma unroll
        for (int j = 0; j < 6; ++j) { const int ch = 2 * lane + 128 * (j >> 1) + (j & 1);
            u32x4 o; o.x = pk2(val[0][j], val[1][j]); o.y = pk2(val[2][j], val[3][j]); o.z = pk2(val[4][j], val[5][j]); o.w = pk2(val[6][j], val[7][j]);
            *(LAS u32x4*)(vT + ch * VP + q0) = o; }
    }
    __syncthreads();
    {
        const int fr = lane & 15, fq = lane >> 4;
        for (int st = wave; st < 24; st += 8) {
            const int h = st >> 2, p0 = (st & 3) * 32;
            f32x4 acc[2][4];
#pragma unroll
            for (int mi = 0; mi < 2; ++mi)
#pragma unroll
                for (int ni = 0; ni < 4; ++ni) acc[mi][ni] = (f32x4){0.f, 0.f, 0.f, 0.f};
#pragma unroll
            for (int ks = 0; ks < 4; ++ks) {
                bf16x8 af[2], bfr[4];
#pragma unroll
                for (int mi = 0; mi < 2; ++mi) af[mi] = *(const bf16x8*)(SW + ((size_t)(l * 6 + h) * 128 + p0 + 16 * mi + fr) * 128 + ks * 32 + fq * 8);
#pragma unroll
                for (int ni = 0; ni < 4; ++ni) bfr[ni] = *(const LAS bf16x8*)(vT + (h * 64 + 16 * ni + fr) * VP + ks * 32 + fq * 8);
#pragma unroll
                for (int mi = 0; mi < 2; ++mi)
#pragma unroll
                    for (int ni = 0; ni < 4; ++ni) acc[mi][ni] = __builtin_amdgcn_mfma_f32_16x16x32_bf16(bfr[ni], af[mi], acc[mi][ni], 0, 0, 0);
            }
#pragma unroll
            for (int mi = 0; mi < 2; ++mi) {
                const int p = p0 + 16 * mi + fr; const float bias = F.A->in[15][(size_t)(l * 6 + h) * 128 + p];
                const size_t tok = (size_t)(b * SEQ + s0 + p);
#pragma unroll
                for (int ni = 0; ni < 4; ++ni) {
                    const int d = 16 * ni + 4 * fq;
                    const u32x2 uv = *(const u32x2*)(ZM + tok * NMAIN + 768 + h * 64 + d);
                    const float o0 = gelu_tanh(bflo(uv.x)) * (acc[mi][ni][0] + bias), o1 = gelu_tanh(bfhi(uv.x)) * (acc[mi][ni][1] + bias);
                    const float o2 = gelu_tanh(bflo(uv.y)) * (acc[mi][ni][2] + bias), o3 = gelu_tanh(bfhi(uv.y)) * (acc[mi][ni][3] + bias);
                    *(u32x2*)(MIX + tok * DM + 640 + h * 64 + d) = (u32x2){pk2(o0, o1), pk2(o2, o3)};
                }
            }
        }
    }
    __syncthreads();
}

__device__ __forceinline__ void dft_stage1(Frame& F) {
    PHASE_LOCALS(F);
    const int fr = lane & 15, fq = lane >> 4;
    const bf16* ZT = (const bf16*)(ws + WS_ZT); bf16* TG = (bf16*)(ws + WS_TG); const bf16* FT1 = (const bf16*)(ws + WS_FT1);
    bf16x8 bfr[8][4];
#pragma unroll
    for (int ni = 0; ni < 8; ++ni)
#pragma unroll
        for (int ks = 0; ks < 4; ++ks) bfr[ni][ks] = *(const bf16x8*)(FT1 + (16 * ni + fr) * 128 + ks * 32 + fq * 8);
    const int gw = F.vcu * NWAVES + wave, NGW = F.G * NWAVES;
    for (int mt = gw; mt < NB_ * FOURW * 64 / 16; mt += NGW) {
        const int row = mt * 16 + fr;
        bf16x8 a[4];
#pragma unroll
        for (int ks = 0; ks < 4; ++ks) a[ks] = *(const bf16x8*)(ZT + (size_t)row * 128 + ks * 32 + fq * 8);
        f32x4 acc[8];
#pragma unroll
        for (int ni = 0; ni < 8; ++ni) acc[ni] = (f32x4){0.f, 0.f, 0.f, 0.f};
#pragma unroll
        for (int ks = 0; ks < 4; ++ks)
#pragma unroll
            for (int ni = 0; ni < 8; ++ni) acc[ni] = __builtin_amdgcn_mfma_f32_16x16x32_bf16(bfr[ni][ks], a[ks], acc[ni], 0, 0, 0);
        const int s2 = row & 63, col = (row >> 6) & 255, b = row >> 14;
#pragma unroll
        for (int ni = 0; ni < 8; ++ni)
#pragma unroll
            for (int h = 0; h < 2; ++h) {
                const int k1 = 8 * ni + 2 * fq + h; const float re = acc[ni][2 * h], im = acc[ni][2 * h + 1];
                const float x = (float)(s2 * k1) * (1.0f / 4096.0f); const float c = __builtin_amdgcn_cosf(x), sn = __builtin_amdgcn_sinf(x);
                bf16* dst = TG + ((size_t)((b * 64 + k1) * 256 + col)) * 128 + s2;
                dst[0] = (bf16)f2bf(c * re - sn * im); dst[64] = (bf16)f2bf(sn * re + c * im);
            }
    }
}
__device__ __forceinline__ void dft_stage2(Frame& F) {
    PHASE_LOCALS(F);
    const int fr = lane & 15, fq = lane >> 4;
    const bf16* TG = (const bf16*)(ws + WS_TG); bf16* MIX = (bf16*)(ws + WS_MIX); const bf16* FT2 = (const bf16*)(ws + WS_FT2);
    bf16x8 bfr[4][4];
#pragma unroll
    for (int ni = 0; ni < 4; ++ni)
#pragma unroll
        for (int ks = 0; ks < 4; ++ks) bfr[ni][ks] = *(const bf16x8*)(FT2 + (16 * ni + fr) * 128 + ks * 32 + fq * 8);
    const int gw = F.vcu * NWAVES + wave, NGW = F.G * NWAVES;
    for (int mt = gw; mt < NB_ * FOURW * 64 / 16; mt += NGW) {
        const int row = mt * 16 + fr;
        bf16x8 a[4];
#pragma unroll
        for (int ks = 0; ks < 4; ++ks) a[ks] = *(const bf16x8*)(TG + (size_t)row * 128 + ks * 32 + fq * 8);
        f32x4 acc[4];
#pragma unroll
        for (int ni = 0; ni < 4; ++ni) acc[ni] = (f32x4){0.f, 0.f, 0.f, 0.f};
#pragma unroll
        for (int ks = 0; ks < 4; ++ks)
#pragma unroll
            for (int ni = 0; ni < 4; ++ni) acc[ni] = __builtin_amdgcn_mfma_f32_16x16x32_bf16(bfr[ni][ks], a[ks], acc[ni], 0, 0, 0);
        const int col = row & 255, k1 = (row >> 8) & 63, b = row >> 14;
#pragma unroll
        for (int ni = 0; ni < 4; ++ni)
#pragma unroll
            for (int j = 0; j < 4; ++j) { const int k2 = 16 * ni + 4 * fq + j;
                MIX[(size_t)(b * SEQ + k1 + 64 * k2) * DM + CONVW + col] = (bf16)f2bf(acc[ni][j]); }
    }
}

__device__ __forceinline__ void router_phase(Frame& F, int l, int lc) {
    PHASE_LOCALS(F);
    const float* MOD = (const float*)(ws + WS_MOD);
    const bf16* XA = (const bf16*)(ws + WS_XA); bf16* HB = (bf16*)(ws + WS_HB); const bf16* RT = (const bf16*)(ws + WS_ROUTERT);
    int* LIST = (int*)(ws + WS_LIST); float* GWL = (float*)(ws + WS_GWL); unsigned char* H8 = ws + WS_H8;
    LAS float* LG = (LAS float*)F.lds;
    LAS int* hist = (LAS int*)(F.lds + 33280);
    LAS int* hbase = (LAS int*)(F.lds + 33280 + 256);
    LAS int* sel_e = (LAS int*)(F.lds + 33280 + 512);
    LAS int* sel_p = (LAS int*)(F.lds + 33280 + 512 + 1024);
    LAS float* sel_w = (LAS float*)(F.lds + 33280 + 512 + 2048);
    for (int blk = F.bx; blk < NTOK / 128; blk += F.G) {
        const int rowbase = blk * 128, b = rowbase >> 12;
        if (tid < 64) hist[tid] = 0;
        {
            f32x4 gs[4], sh[4];
            const float* mp = MOD + ((size_t)l * 8 + b) * NMOD + 3 * DM + 4 * lane;
#pragma unroll
            for (int j = 0; j < 4; ++j) { const f32x4 g = *(const f32x4*)(F.A->in[3] + (size_t)l * DM + 4 * lane + 256 * j), scl = *(const f32x4*)(mp + DM + 256 * j); gs[j] = g * (scl + 1.0f); sh[j] = *(const f32x4*)(mp + 256 * j); }
            for (int i0 = 0; i0 < 16; i0 += 4) {
                u32x2 xx[4][4];
#pragma unroll
                for (int i = 0; i < 4; ++i)
#pragma unroll
                    for (int j = 0; j < 4; ++j) xx[i][j] = *(const u32x2*)(XA + (size_t)(rowbase + wave * 16 + i0 + i) * DM + 4 * lane + 256 * j);
#pragma unroll
                for (int i = 0; i < 4; ++i) {
                    const int row = rowbase + wave * 16 + i0 + i;
                    f32x4 v[4]; float ss = 0.f;
#pragma unroll
                    for (int j = 0; j < 4; ++j) { v[j] = (f32x4){bflo(xx[i][j].x), bfhi(xx[i][j].x), bflo(xx[i][j].y), bfhi(xx[i][j].y)}; ss += (v[j].x * v[j].x + v[j].y * v[j].y) + (v[j].z * v[j].z + v[j].w * v[j].w); }
                    const float rs = rsqrtf(wave_sum(ss) * (1.0f / DM) + EPS);
#pragma unroll
                    for (int j = 0; j < 4; ++j) { const f32x4 h = v[j] * rs * gs[j] + sh[j];
                        *(u32x2*)(HB + (size_t)row * DM + 4 * lane + 256 * j) = (u32x2){pk2(h.x, h.y), pk2(h.z, h.w)};
                        *(unsigned*)(H8 + (size_t)row * DM + 4 * lane + 256 * j) = pk4_fp8(clamp448(h.x), clamp448(h.y), clamp448(h.z), clamp448(h.w)); }
                }
            }
        }
        VM_WAIT(); __syncthreads();
        {
            const int fr = lane & 15, fq = lane >> 4; const int row = rowbase + wave * 16 + fr;
            f32x4 acc[4];
#pragma unroll
            for (int ni = 0; ni < 4; ++ni) acc[ni] = (f32x4){0.f, 0.f, 0.f, 0.f};
#pragma unroll 8
            for (int ks = 0; ks < 32; ++ks) {
                const bf16x8 a = *(const bf16x8*)(HB + (size_t)row * DM + ks * 32 + fq * 8);
#pragma unroll
                for (int ni = 0; ni < 4; ++ni) { const bf16x8 bb = *(const bf16x8*)(RT + (size_t)(16 * ni + fr) * DM + ks * 32 + fq * 8); acc[ni] = __builtin_amdgcn_mfma_f32_16x16x32_bf16(bb, a, acc[ni], 0, 0, 0); }
            }
#pragma unroll
            for (int ni = 0; ni < 4; ++ni)
#pragma unroll
                for (int j = 0; j < 4; ++j) LG[(wave * 16 + fr) * 65 + 16 * ni + 4 * fq + j] = acc[ni][j];
        }
        __syncthreads();
        if (lane < 16) {
            const int r = wave * 16 + lane; const LAS float* lg = LG + r * 65;
            float mx = lg[0];
            for (int e = 1; e < 64; ++e) mx = fmaxf(mx, lg[e]);
            float sum = 0.f;
            for (int e = 0; e < 64; ++e) sum += __expf(lg[e] - mx);
            const float inv = 1.0f / sum;
            float best = -1e30f; int bg = 0;
            for (int g = 0; g < 8; ++g) {
                float v1 = -1e30f, v2 = -1e30f;
                for (int i = 0; i < 8; ++i) { const float sv = __expf(lg[g * 8 + i] - mx) * inv + F.A->in[17][g * 8 + i]; if (sv > v1) { v2 = v1; v1 = sv; } else if (sv > v2) v2 = sv; }
                const float gs = v1 + v2; if (gs > best) { best = gs; bg = g; }
            }
            float v1 = -1e30f, v2 = -1e30f; int i1 = 0, i2 = 0;
            for (int i = 0; i < 8; ++i) { const float sv = __expf(lg[bg * 8 + i] - mx) * inv + F.A->in[17][bg * 8 + i];
                if (sv > v1) { v2 = v1; i2 = i1; v1 = sv; i1 = i; } else if (sv > v2) { v2 = sv; i2 = i; } }
            const int e0 = bg * 8 + i1, e1 = bg * 8 + i2;
            const float p0 = __expf(lg[e0] - mx) * inv, p1 = __expf(lg[e1] - mx) * inv, den = 1.0f / (p0 + p1);
            sel_e[2 * r] = e0; sel_e[2 * r + 1] = e1; sel_w[2 * r] = p0 * den; sel_w[2 * r + 1] = p1 * den;
            sel_p[2 * r] = atomicAdd((int*)&hist[e0], 1); sel_p[2 * r + 1] = atomicAdd((int*)&hist[e1], 1);
        }
        __syncthreads();
        if (tid < 64) { const int cn = hist[tid]; hbase[tid] = cn ? (int)atomicAdd(F.ctl + CW_CNT + (lc * 64 + tid) * 16, (unsigned)cn) : 0; }
        __syncthreads();
        if (tid < 256) { const int r = tid >> 1, k = tid & 1, e = sel_e[tid], slot = hbase[e] + sel_p[tid], a = (rowbase + r) * 2 + k;
            LIST[(size_t)e * NTOK + slot] = a; GWL[(size_t)e * NTOK + slot] = sel_w[tid]; }
        __syncthreads();
    }
}

__device__ __forceinline__ int moe_setup(Frame& F, int l) {
    PHASE_LOCALS(F);
    volatile LAS int* cnt = (volatile LAS int*)(F.lds + MISC_OFF + M_CNT);
    volatile LAS int* pre = (volatile LAS int*)(F.lds + MISC_OFF + M_PRE);
    volatile LAS unsigned* desc = (volatile LAS unsigned*)(F.lds + MISC_OFF + M_DESC);
    volatile LAS int* nu = (volatile LAS int*)(F.lds + MISC_OFF + M_NU);
    if (tid < 64) cnt[tid] = (int)F.ctl[CW_CNT + (l * 64 + tid) * 16];
    __syncthreads();
    if (tid == 0) {
        int p = 0;
        for (int e = 0; e < 64; ++e) { pre[e] = p; p += (cnt[e] + 255) >> 8; }
        pre[64] = p;
        int n = 0, e = 0;
        for (int L = F.vcu; L < p * 4 && n < 30; L += F.G) { const int blk = L >> 2, pn = L & 3; while (pre[e + 1] <= blk) ++e; desc[n++] = (unsigned)e | ((unsigned)pn << 6) | ((unsigned)(blk - pre[e]) << 8) | ((unsigned)blk << 16); }
        nu[0] = n;
    }
    __syncthreads();
    return __builtin_amdgcn_readfirstlane(nu[0]);
}


#ifndef DBG_CHECK
#define DBG_CHECK 0
#endif
__device__ __forceinline__ float dec8(unsigned b) { b &= 0xff; const unsigned e = (b >> 3) & 15, m = b & 7; const float v = e == 0 ? (float)m * (1.0f / 512.0f) : (float)(8 + m) * __builtin_amdgcn_ldexpf(1.0f, (int)e - 10); return (b & 0x80) ? -v : v; }
__device__ __forceinline__ unsigned hash32(unsigned i) { i *= 2654435761u; i ^= i >> 15; i *= 2246822519u; i ^= i >> 13; i *= 3266489917u; i ^= i >> 16; return i; }
__device__ __forceinline__ void dbg_fail(Frame& F, int k) { atomicMin(F.ctl + CW_CHK, (unsigned)k); }

__device__ __forceinline__ void dbg_check_win(Frame& F, int l) {
    PHASE_LOCALS(F);
    const unsigned gt = F.bx * NTHREADS + tid;
    if (gt < 16384u) { const unsigned h = hash32(gt + 12345u); const int row = h & 32767, col = (h >> 15) % 1536;
        const bf16* HB = (const bf16*)(ws + WS_HB) + (size_t)row * DM; const bf16* WT = (const bf16*)(ws + WS_WINT) + ((size_t)l * NMAIN + col) * DM;
        float s = 0.f, sa = 0.f; for (int k = 0; k < DM; ++k) { const float p = bf2f(HB[k]) * bf2f(WT[k]); s += p; sa += fabsf(p); }
        const float got = bf2f(((const bf16*)(ws + WS_ZMAIN))[(size_t)row * NMAIN + col]);
        if (fabsf(got - s) > 0.01f * fabsf(s) + 1e-3f * sa + 1e-4f) dbg_fail(F, 6); }
}
__device__ __forceinline__ void dbg_check_wout(Frame& F, int l) {
    PHASE_LOCALS(F);
    const unsigned gt = F.bx * NTHREADS + tid;
    if (gt < 16384u) { const unsigned h = hash32(gt + 54321u); const int row = h & 32767, col = (h >> 15) & 1023;
        const bf16* MX = (const bf16*)(ws + WS_MIX) + (size_t)row * DM; const bf16* WT = (const bf16*)(ws + WS_WOUTT) + ((size_t)l * DM + col) * DM;
        float s = 0.f, sa = 0.f; for (int k = 0; k < DM; ++k) { const float p = bf2f(MX[k]) * bf2f(WT[k]); s += p; sa += fabsf(p); }
        const float gate = ((const float*)(ws + WS_MOD))[((size_t)l * 8 + (row >> 12)) * NMOD + 2 * DM + col];
        const float want = F.A->in[0][(size_t)row * DM + col] + gate * s, got = bf2f(((const bf16*)(ws + WS_XA))[(size_t)row * DM + col]);
        if (fabsf(got - want) > 1e-3f * fabsf(gate) * sa + 0.006f * fabsf(want) + 1e-4f) dbg_fail(F, 7); }
}
__device__ __forceinline__ void dbg_checks(Frame& F) {
    PHASE_LOCALS(F);
    const int l = 1;
    const unsigned gt = F.bx * NTHREADS + tid;
    const unsigned char* W13 = ws + WS_W13T; const unsigned char* W2 = ws + WS_W2T; const unsigned char* H8 = ws + WS_H8; const unsigned char* HM = ws + WS_ZMAIN;
    const bf16* HB = (const bf16*)(ws + WS_HB); const bf16* CT = (const bf16*)(ws + WS_CONTRIB); const int* LIST = (const int*)(ws + WS_LIST); const float* GWL = (const float*)(ws + WS_GWL);
    if (gt < 65536u) {
        const unsigned h = hash32(gt);
        { const int le = h & 127, which = (h >> 7) & 1, n = (h >> 8) & 511, k = (h >> 17) & 1023;
          const float w = (which ? F.A->in[19] : F.A->in[18])[((size_t)le * DM + k) * DFF + n] * W8_SCALE;
          const unsigned want = pk4_fp8(w, 0.f, 0.f, 0.f) & 0xff, got = W13[((size_t)le * 1024 + (n >> 7) * 256 + which * 128 + (n & 127)) * DM + k];
          if (want != got) dbg_fail(F, 1); }
        { const int le = h & 127, n = (h >> 7) & 1023, k = (h >> 17) & 511;
          const float w = F.A->in[20][((size_t)le * DFF + k) * DM + n] * W8_SCALE;
          const unsigned want = pk4_fp8(w, 0.f, 0.f, 0.f) & 0xff, got = W2[((size_t)le * 1024 + n) * DFF + k];
          if (want != got) dbg_fail(F, 2); }
        { const int row = h & 32767, c = (h >> 15) & 1023; const float a = bf2f(HB[(size_t)row * DM + c]), b = dec8(H8[(size_t)row * DM + c]);
          if (fabsf(a - b) > 0.07f * fabsf(a) + 0.002f) dbg_fail(F, 3); }
    }
    if (gt < 4096u) {
        const unsigned h = hash32(gt + 99991u);
        const int e = h & 63; const int cnt = (int)F.ctl[CW_CNT + (l * 64 + e) * 16];
        int pre = 0; for (int q = 0; q < e; ++q) pre += ((int)F.ctl[CW_CNT + (l * 64 + q) * 16] + 255) >> 8;
        if (cnt > 0) {
            const int p = (int)((h >> 6) % (unsigned)cnt), a = LIST[(size_t)e * NTOK + p], tok = a >> 1; const size_t prow = (size_t)pre * 256 + p;
            { const int c = (h >> 20) & 511; float g = 0.f, u = 0.f;
              const unsigned char* w1r = W13 + (((size_t)(l * 64 + e)) * 1024 + (c >> 7) * 256 + (c & 127)) * DM; const unsigned char* w3r = w1r + 128 * DM;
              for (int k = 0; k < DM; ++k) { const float x = dec8(H8[(size_t)tok * DM + k]); g += x * dec8(w1r[k]); u += x * dec8(w3r[k]); }
              g *= 1.0f / W8_SCALE; u *= 1.0f / W8_SCALE; const float want = g * sigmoidf_(g) * u * H8_SCALE, got = dec8(HM[prow * DFF + c]);
              if (fabsf(want - got) > 0.08f * fabsf(want) + 0.01f) dbg_fail(F, 4); }
            { const int c = (h >> 12) & 1023; float y = 0.f; const unsigned char* w2r = W2 + (((size_t)(l * 64 + e)) * 1024 + c) * DFF;
              for (int k = 0; k < DFF; ++k) y += dec8(HM[prow * DFF + k]) * dec8(w2r[k]);
              const float want = y * GWL[(size_t)e * NTOK + p] * (1.0f / (W8_SCALE * H8_SCALE)), got = bf2f(CT[(size_t)a * DM + c]);
              if (fabsf(want - got) > 0.02f * fabsf(want) + 0.002f) dbg_fail(F, 5); }
        }
    }
}

constexpr int N_PHASES = 18;
__global__ void __launch_bounds__(NTHREADS, 2) fwd_kernel(Args args) {
    extern __shared__ __attribute__((aligned(16))) unsigned char lds_raw[];
    Frame F;
    F.lds = (LAS unsigned char*)lds_raw;
    F.G = gridDim.x; F.bx = blockIdx.x; F.vcu = (F.G % 8 == 0) ? (F.bx % 8) * (F.G / 8) + F.bx / 8 : F.bx;
    F.ws = args.ws; F.ctl = (unsigned*)(args.ws + WS_CTL); F.out = args.out;
    F.A = &args;
    for (int u = threadIdx.x; u < (LDS_BYTES - MISC_OFF) / 4; u += NTHREADS) ((LAS unsigned*)(F.lds + MISC_OFF))[u] = 0u;
    __syncthreads();
    XcdBarrier bar; bar.bar = F.ctl + CW_BAR; bar.x = 0; bar.st = nullptr;
    if (!MK_PER_PHASE) bar = xcd_barrier_post(F.ctl + CW_BAR, (volatile LAS unsigned*)(F.lds + MISC_OFF + M_BAR));
    const int lo = args.ph_lo, hi = args.ph_hi;
#if DBG_CHECK
    if (blockIdx.x == 0 && threadIdx.x == 0) __hip_atomic_store(F.ctl + CW_CHK, 0xFFFFFFFFu, RLX_AGENT);
#endif
#define IN(k) (lo <= (k) && (k) < hi)
#define GRID_BAR() do { if (!MK_PER_PHASE) xcd_barrier(bar); } while (0)

    if (IN(0)) { for (int rep = 0; rep < REPS(0); ++rep) { p0_prologue(F); GRID_BAR(); } }

    for (int l = 0; l < 2; ++l) {
        const int pb = 1 + 8 * l;
        if (IN(pb + 0)) { for (int rep = 0; rep < (l == 0 ? REPS(1) : 1); ++rep) { norm_phase(F, l == 0 ? 0 : 1, l); GRID_BAR(); } }
        if (IN(pb + 1)) { for (int rep = 0; rep < REPS(2); ++rep) {
            PHASE_LOCALS(F);
            SchedWin S; S.sm.init(NTOK, NMAIN); S.G = F.G; S.c = F.bx; S.hb = (const char*)(ws + WS_HB);
            S.wmain = (const char*)(ws + WS_WINT) + (size_t)l * NMAIN * DM * 2; S.wf = (const char*)(ws + WS_WINF) + (size_t)l * NFOUR * DM * 2;
            EpiWin E{(bf16*)(ws + WS_ZMAIN), (bf16*)(ws + WS_ZT)};
            pg8::gemm_phase<EpiWin, SchedWin, true>(F.lds, DM, S, E);
            GRID_BAR(); }
#if DBG_CHECK
            if (l == 0) { dbg_check_win(F, l); GRID_BAR(); }
#endif
        }
        if (IN(pb + 2)) { for (int rep = 0; rep < REPS(3); ++rep) {
            for (int r2 = 0; r2 < REPS(11); ++r2) dft_stage1(F);
            for (int r2 = 0; r2 < REPS(9); ++r2) for (int u = F.vcu; u < 1536; u += F.G) conv_unit(F, l, u);
            for (int r2 = 0; r2 < REPS(10); ++r2) for (int u = F.vcu; u < 256; u += F.G) sgu_unit(F, l, u);
            GRID_BAR(); }
        }
        if (IN(pb + 3)) { for (int rep = 0; rep < REPS(5); ++rep) { dft_stage2(F); GRID_BAR(); } }
        if (IN(pb + 4)) { for (int rep = 0; rep < (l == 0 ? REPS(4) : 1); ++rep) {
            PHASE_LOCALS(F);
            SchedWout S; S.sm.init(NTOK, DM); S.G = F.G; S.c = F.bx; S.mix = (const char*)(ws + WS_MIX); S.wt = (const char*)(ws + WS_WOUTT) + (size_t)l * DM * DM * 2;
            EpiWout E{l == 0 ? F.A->in[0] : (const float*)nullptr, (bf16*)(ws + WS_XA), (const float*)(ws + WS_MOD) + (size_t)l * 8 * NMOD + 2 * DM};
            pg8::gemm_phase<EpiWout, SchedWout, true>(F.lds, DM, S, E);
            GRID_BAR(); }
#if DBG_CHECK
            if (l == 0) { dbg_check_wout(F, l); GRID_BAR(); }
#endif
        }
        if (IN(pb + 5)) { if (REPS(12) == 2) { router_phase(F, l, 2 + l); GRID_BAR(); } router_phase(F, l, l); GRID_BAR(); }
        if (IN(pb + 6)) { for (int rep = 0; rep < REPS(6); ++rep) {
            PHASE_LOCALS(F);
            const int nu = moe_setup(F, l);
            SchedMoe S; S.desc = (const volatile LAS unsigned*)(F.lds + MISC_OFF + M_DESC); S.cnt = (const volatile LAS int*)(F.lds + MISC_OFF + M_CNT); S.nu = nu; S.which = 1;
            S.hb = (const char*)(ws + WS_H8); S.hmoe = (const char*)(ws + WS_ZMAIN); S.wt = (const char*)(ws + WS_W13T) + (size_t)l * 64 * 1024 * DM; S.list = (const int*)(ws + WS_LIST);
            EpiMoe1 E{ws + WS_ZMAIN};
            pg8::gemm_phase<EpiMoe1, SchedMoe, true, true>(F.lds, DM / 2, S, E);
            GRID_BAR(); }
        }
        if (IN(pb + 7)) { for (int rep = 0; rep < REPS(7); ++rep) {
            PHASE_LOCALS(F);
            const int nu = moe_setup(F, l);
            SchedMoe S; S.desc = (const volatile LAS unsigned*)(F.lds + MISC_OFF + M_DESC); S.cnt = (const volatile LAS int*)(F.lds + MISC_OFF + M_CNT); S.nu = nu; S.which = 2;
            S.hb = (const char*)(ws + WS_H8); S.hmoe = (const char*)(ws + WS_ZMAIN); S.wt = (const char*)(ws + WS_W2T) + (size_t)l * 64 * 1024 * DFF; S.list = (const int*)(ws + WS_LIST);
            EpiMoe2 E{(bf16*)(ws + WS_CONTRIB), (const int*)(ws + WS_LIST), (const float*)(ws + WS_GWL)};
            pg8::gemm_phase<EpiMoe2, SchedMoe, true, true>(F.lds, DFF / 2, S, E);
            GRID_BAR(); }
        }
    }
    if (IN(17)) {
        for (int rep = 0; rep < REPS(8); ++rep) norm_phase(F, 2, 2);
#if DBG_CHECK
        xcd_barrier(bar);
#endif
        if (!MK_PER_PHASE) {
            if (xb_ld(F.ctl + CW_BAR + XB_TMO) != 0u) { VM_WAIT(); __syncthreads(); const float q = __builtin_nanf("");
                for (size_t i = (size_t)F.bx * NTHREADS + threadIdx.x; i < (size_t)NTOK * DM; i += (size_t)F.G * NTHREADS) F.out[i] = q; }
        }
    }
#if DBG_CHECK
    if (IN(17)) {
        dbg_checks(F); xcd_barrier(bar);
        const unsigned code = xb_ld(F.ctl + CW_CHK);
        if (code != 0xFFFFFFFFu) { const float q = 1000.0f * (float)code; for (size_t i = (size_t)F.bx * NTHREADS + threadIdx.x; i < (size_t)NTOK * DM; i += (size_t)F.G * NTHREADS) F.out[i] = q; }
    }
#endif
#undef IN
#undef GRID_BAR
}

extern "C" void kernel_launch(void* const* d_in, const int* in_sizes, int n_in, void* d_out, int out_size, void* d_ws, size_t ws_size, hipStream_t stream) {
    static int grid = 0;
    if (grid == 0) {
        if (n_in != 22 || out_size != NTOK * DM || ws_size < WS_END) { fprintf(stderr, "kernel_launch: unexpected shapes (n_in %d, out %d, ws %zu, need %zu)\n", n_in, out_size, ws_size, (size_t)WS_END); grid = -1; return; }
        int dev = 0, cus = 0, per_cu = 0;
        if (hipGetDevice(&dev) != hipSuccess || hipDeviceGetAttribute(&cus, hipDeviceAttributeMultiprocessorCount, dev) != hipSuccess) { grid = -1; return; }
        if (hipFuncSetAttribute((const void*)fwd_kernel, hipFuncAttributeMaxDynamicSharedMemorySize, LDS_BYTES) != hipSuccess) { fprintf(stderr, "kernel_launch: hipFuncSetAttribute failed\n"); grid = -1; return; }
        if (hipOccupancyMaxActiveBlocksPerMultiprocessor(&per_cu, (const void*)fwd_kernel, NTHREADS, LDS_BYTES) != hipSuccess || per_cu < 1) fprintf(stderr, "kernel_launch: occupancy query says %d\n", per_cu);
        (void)hipGetLastError();
        grid = cus;
        if (grid != 256) fprintf(stderr, "kernel_launch: %d CUs (built for 256)\n", grid);
    }
    if (grid < 0) return;
    (void)hipMemsetAsync((char*)d_ws + WS_CTL, 0, CTL_ZERO_BYTES, stream);
    Args a{};
    for (int i = 0; i < 22; ++i) a.in[i] = (const float*)d_in[i];
    a.out = (float*)d_out; a.ws = (unsigned char*)d_ws;
#if MK_PER_PHASE
    for (int p = 0; p < N_PHASES; ++p) { a.ph_lo = p; a.ph_hi = p + 1; hipLaunchKernelGGL(fwd_kernel, dim3(grid), dim3(NTHREADS), LDS_BYTES, stream, a); }
#else
    a.ph_lo = 0; a.ph_hi = N_PHASES;
    hipLaunchKernelGGL(fwd_kernel, dim3(grid), dim3(NTHREADS), LDS_BYTES, stream, a);
#endif
}
```
